# Optimizing an MI355X kernel written in HIP

```python
import math
import jax, jax.numpy as jnp
from jax import lax
import numpy as np

D_MODEL = 1024
BATCH = 32
SEQ = 256
DEPTH = 4
DEC_BATCH = 8
DEC_SEQ = 1024
PAST_LEN = 256

GRID_W = 64
HEAD_DIM = 64
N_HEADS_A = 8
N_HEADS_B = 8
D_A = N_HEADS_A * HEAD_DIM
D_B = N_HEADS_B * HEAD_DIM
WIN_R = 8
WIN_C = 16
Q_BLK_C = 16
K_BAND_C = 32
N_HEADS_C = 8
DK_C = D_MODEL // N_HEADS_C
DV_C = D_MODEL // N_HEADS_C
D_C = N_HEADS_C * DK_C
D_IN_EVEN = 3 * D_A + 4 * D_B
D_IN_ODD = 5 * D_C
D_FF = ((8 * D_MODEL // 3 + 255) // 256) * 256
RET_CHUNK = 64
HGRN_CHUNK = 32
ROPE_BASE = 10000.0
EPS = 1e-6
MASK_NEG = -1e30
F_MIN = 1e-30
N_EVEN = (DEPTH + 1) // 2
N_ODD = DEPTH // 2

kernel_name = "hybrid_na_retention_hgrn2_diffusion_step"

F32 = jnp.float32


def _rmsnorm(x, g=None):
    xf = x.astype(F32)
    y = xf * lax.rsqrt(jnp.mean(xf * xf, axis=-1, keepdims=True) + EPS)
    if g is not None:
        y = y * g.astype(F32)
    return y.astype(x.dtype)


def _heads(a, dh):
    b, t, _ = a.shape
    return a.reshape(b, t, -1, dh).transpose(0, 2, 1, 3)


def _merge(a):
    b, h, t, d = a.shape
    return a.transpose(0, 2, 1, 3).reshape(b, t, h * d)


def _flip(a):
    return jnp.flip(a, axis=2)


def _modulation(cvec, w_mod, b_mod):
    m = jax.nn.silu(cvec) @ w_mod + b_mod
    return jnp.split(m[..., None, :], 6, axis=-1)


def _axial_rope(x):
    n = x.shape[-2]
    t = jnp.arange(n)
    half = HEAD_DIM // 2
    nf = half // 2
    inv = ROPE_BASE ** (-jnp.arange(nf, dtype=F32) / nf)

    def rot(xa, pos):
        ang = pos.astype(F32)[:, None] * inv[None, :]
        cos, sin = jnp.cos(ang), jnp.sin(ang)
        x1, x2 = xa[..., :nf], xa[..., nf:]
        return jnp.concatenate([x1 * cos - x2 * sin, x1 * sin + x2 * cos], axis=-1)

    xf = x.astype(F32)
    out = jnp.concatenate([rot(xf[..., :half], t // GRID_W), rot(xf[..., half:], t % GRID_W)], axis=-1)
    return out.astype(x.dtype)


def _retention_scan(q, k, v, log_g, s0):
    b, h, t, dk = q.shape
    dv = v.shape[-1]
    c = RET_CHUNK
    n = t // c

    def chunks(a):
        return jnp.moveaxis(a.astype(F32).reshape(b, h, n, c, a.shape[-1]), 2, 0)

    pos = jnp.arange(c, dtype=F32)
    diff = pos[:, None] - pos[None, :]
    dmask = jnp.where(diff >= 0, jnp.exp(log_g[:, None, None] * jnp.maximum(diff, 0.0)), 0.0)
    q_dec = jnp.exp(log_g[:, None] * (pos + 1.0))[:, :, None]
    k_dec = jnp.exp(log_g[:, None] * (c - 1.0 - pos))[:, :, None]
    s_dec = jnp.exp(log_g * c)[:, None, None]

    def step(s, xs):
        qi, ki, vi = xs
        att = jnp.einsum('bhid,bhjd->bhij', qi, ki) * dmask
        o = jnp.einsum('bhij,bhjv->bhiv', att, vi) + jnp.einsum('bhid,bhdv->bhiv', qi * q_dec, s)
        s = s * s_dec + jnp.einsum('bhjd,bhjv->bhdv', ki * k_dec, vi)
        return s, o

    s_fin, o = lax.scan(step, s0.astype(F32), (chunks(q), chunks(k), chunks(v)))
    return jnp.moveaxis(o, 0, 2).reshape(b, h, t, dv), s_fin


def _gla_scan(q, k, v, log_f, s0):
    b, h, t, dk = q.shape
    dv = v.shape[-1]
    c = HGRN_CHUNK
    n = t // c

    def chunks(a):
        return jnp.moveaxis(a.astype(F32).reshape(b, h, n, c, a.shape[-1]), 2, 0)

    causal = jnp.tril(jnp.ones((c, c), dtype=bool))[:, :, None]

    def step(s, xs):
        qi, ki, vi, fi = xs
        bcum = jnp.cumsum(fi, axis=2)
        rel = bcum[:, :, :, None, :] - bcum[:, :, None, :, :]
        dec = jnp.where(causal, jnp.exp(jnp.minimum(rel, 0.0)), 0.0)
        att = jnp.einsum('bhtd,bhsd,bhtsd->bhts', qi, ki, dec)
        o = jnp.einsum('bhts,bhsv->bhtv', att, vi) + jnp.einsum('bhtd,bhdv->bhtv', qi * jnp.exp(bcum), s)
        blast = bcum[:, :, -1:, :]
        s = s * jnp.exp(blast[:, :, 0, :, None]) + jnp.einsum('bhsd,bhsv->bhdv', ki * jnp.exp(blast - bcum), vi)
        return s, o

    s_fin, o = lax.scan(step, s0.astype(F32), (chunks(q), chunks(k), chunks(v), chunks(log_f)))
    return jnp.moveaxis(o, 0, 2).reshape(b, h, t, dv), s_fin


def _even_project(h, w_in):
    z = h @ w_in
    parts = jnp.split(z, [D_A, 2 * D_A, 3 * D_A, 3 * D_A + D_B, 3 * D_A + 2 * D_B, 3 * D_A + 3 * D_B], axis=-1)
    return [_heads(p, HEAD_DIM) for p in parts]


def _attend_context(q, k, v):
    s = jnp.einsum('bhqd,bhkd->bhqk', q, k).astype(F32) * (HEAD_DIM ** -0.5)
    p = jax.nn.softmax(s, axis=-1).astype(v.dtype)
    return jnp.einsum('bhqk,bhkd->bhqd', p, v)


def _neighbourhood_attend(q, k, v, k_ctx, v_ctx, rpb):
    b, h, n, dh = q.shape
    rows = n // GRID_W
    wr = min(WIN_R, rows)
    nblk = GRID_W // Q_BLK_C
    r = jnp.arange(rows)
    row_idx = jnp.clip(r - wr // 2, 0, rows - wr)[:, None] + jnp.arange(wr)[None, :]
    qcol = jnp.arange(GRID_W).reshape(nblk, Q_BLK_C)
    band0 = jnp.clip(qcol[:, 0] - WIN_C // 2, 0, GRID_W - K_BAND_C)
    col_idx = band0[:, None] + jnp.arange(K_BAND_C)[None, :]
    win0 = jnp.clip(qcol - WIN_C // 2, 0, GRID_W - WIN_C)
    valid = (col_idx[:, None, :] >= win0[:, :, None]) & (col_idx[:, None, :] < win0[:, :, None] + WIN_C)
    row_off = row_idx - r[:, None] + (WIN_R - 1)
    col_off = jnp.clip(col_idx[:, None, :] - qcol[:, :, None], 1 - WIN_C, WIN_C - 1) + (WIN_C - 1)
    bias = rpb.astype(F32)[:, row_off[:, None, None, :, None], col_off[None, :, :, None, :]]

    def band(a):
        return a.reshape(b, h, rows, GRID_W, dh)[:, :, row_idx][:, :, :, :, col_idx]

    scale = HEAD_DIM ** -0.5
    qg = q.reshape(b, h, rows, nblk, Q_BLK_C, dh)
    s_loc = jnp.einsum('bhrjqd,bhrwjkd->bhrjqwk', qg, band(k)).astype(F32) * scale + bias[None]
    s_loc = jnp.where(valid[:, :, None, :], s_loc, MASK_NEG)
    s_ctx = jnp.einsum('bhrjqd,bhpd->bhrjqp', qg, k_ctx).astype(F32) * scale
    nl = wr * K_BAND_C
    s = jnp.concatenate([s_loc.reshape(b, h, rows, nblk, Q_BLK_C, nl), s_ctx], axis=-1)
    p = jax.nn.softmax(s, axis=-1).astype(v.dtype)
    p_loc = p[..., :nl].reshape(b, h, rows, nblk, Q_BLK_C, wr, K_BAND_C)
    o = (jnp.einsum('bhrjqwk,bhrwjkd->bhrjqd', p_loc, band(v))
         + jnp.einsum('bhrjqp,bhpd->bhrjqd', p[..., nl:], v_ctx))
    return o.reshape(b, h, n, dh)


def _retention_bidir(q, k, v, g, ret_decay, s0):
    log_g = -jnp.exp(ret_decay.astype(F32))
    k = k * (HEAD_DIM ** -0.5)
    o_f, s_f = _retention_scan(q, k, v, log_g[0], s0[:, 0])
    o_b, s_b = _retention_scan(_flip(q), _flip(k), _flip(v), log_g[1], s0[:, 1])
    o = _rmsnorm(o_f + _flip(o_b)) * jax.nn.silu(g.astype(F32))
    return o.astype(q.dtype), jnp.stack([s_f, s_b], axis=1)


def _hgrn_bidir(h, w_in, w_out, lb, gnorm, s0):
    z = h @ w_in
    q, f_fw, f_bw, i, g = [_heads(p, DK_C) for p in jnp.split(z, 5, axis=-1)]
    q = jax.nn.silu(q.astype(F32)) * (DK_C ** -0.5)

    def gates(fr, lbd):
        lbh = lbd.reshape(N_HEADS_C, 1, DK_C)
        frf = fr.astype(F32)
        f = lbh + (1.0 - lbh) * jax.nn.sigmoid(frf)
        inp = (1.0 - lbh) * jax.nn.sigmoid(-frf)
        return jnp.log(jnp.maximum(f, F_MIN)), inp

    lf_f, k_f = gates(f_fw, lb[0])
    lf_b, k_b = gates(f_bw, lb[1])
    v = i.astype(F32)
    o_f, s_f = _gla_scan(q, k_f, v, lf_f, s0[:, 0])
    o_b, s_b = _gla_scan(_flip(q), _flip(k_b), _flip(v), _flip(lf_b), s0[:, 1])
    o = _rmsnorm(o_f + _flip(o_b), gnorm) * jax.nn.silu(g.astype(F32))
    return _merge(o.astype(h.dtype)) @ w_out, jnp.stack([s_f, s_b], axis=1)


def _swiglu(h, w_in, w_out):
    a, u = jnp.split(h @ w_in, 2, axis=-1)
    return (jax.nn.silu(a) * u) @ w_out


def setup_inputs(seed: int = 0) -> dict:
    key = jax.random.key(seed)
    ks = jax.random.split(key, 20)

    def nrm(k, shape, s):
        return jax.random.normal(k, shape, F32) * s

    ret_base = jnp.log(-jnp.log(1.0 - jnp.power(2.0, -5.0 - jnp.arange(N_HEADS_B, dtype=F32))))
    return {
        "x_prompt": nrm(ks[0], (BATCH, SEQ, D_MODEL), 1.0),
        "x_sample": nrm(ks[1], (DEC_BATCH, DEC_SEQ, D_MODEL), 1.0),
        "cache_kv": nrm(ks[2], (DEC_BATCH, N_EVEN, 2, N_HEADS_A, PAST_LEN, HEAD_DIM), 1.0),
        "state_ret": nrm(ks[3], (DEC_BATCH, N_EVEN, 2, N_HEADS_B, HEAD_DIM, HEAD_DIM), 0.5),
        "state_hgrn": nrm(ks[4], (DEC_BATCH, N_ODD, 2, N_HEADS_C, DK_C, DV_C), 0.5),
        "c": nrm(ks[5], (DEC_BATCH, D_MODEL), 1.0),
        "c_ctx": nrm(ks[6], (D_MODEL,), 1.0),
        "w_mod": nrm(ks[7], (DEPTH, D_MODEL, 6 * D_MODEL), 0.5 * D_MODEL ** -0.5),
        "b_mod": nrm(ks[8], (DEPTH, 6 * D_MODEL), 0.02),
        "norm_g": 1.0 + nrm(ks[9], (DEPTH, 4, D_MODEL), 0.02),
        "w_in_even": nrm(ks[10], (N_EVEN, D_MODEL, D_IN_EVEN), D_MODEL ** -0.5),
        "w_out_even": nrm(ks[11], (N_EVEN, D_A + D_B, D_MODEL), (D_A + D_B) ** -0.5),
        "rpb": nrm(ks[12], (N_EVEN, N_HEADS_A, 2 * WIN_R - 1, 2 * WIN_C - 1), 0.1),
        "ret_decay": ret_base + nrm(ks[13], (N_EVEN, 2, N_HEADS_B), 0.1),
        "w_in_odd": nrm(ks[14], (N_ODD, D_MODEL, D_IN_ODD), D_MODEL ** -0.5),
        "w_out_odd": nrm(ks[15], (N_ODD, D_C, D_MODEL), D_C ** -0.5),
        "hgrn_lb": nrm(ks[16], (N_ODD, 2, D_C), 1.0),
        "hgrn_gnorm": 1.0 + nrm(ks[17], (N_ODD, DV_C), 0.02),
        "w_ffn_in": nrm(ks[18], (DEPTH, D_MODEL, 2 * D_FF), D_MODEL ** -0.5),
        "w_ffn_out": nrm(ks[19], (DEPTH, D_FF, D_MODEL), D_FF ** -0.5),
    }


def reference(x_prompt, x_sample, cache_kv, state_ret, state_hgrn, c, c_ctx, w_mod, b_mod, norm_g,
              w_in_even, w_out_even, rpb, ret_decay, w_in_odd, w_out_odd, hgrn_lb, hgrn_gnorm,
              w_ffn_in, w_ffn_out):
    p_lb = jax.nn.softmax(hgrn_lb.astype(F32), axis=0)
    lower = jnp.clip(jnp.cumsum(p_lb, axis=0) - p_lb[0], 0.0, 1.0)
    bp = x_prompt.shape[0]
    xp, xs = x_prompt, x_sample
    kv_states, ret_states, hg_states = [], [], []
    for l in range(DEPTH):
        sh1p, sc1p, gt1p, sh2p, sc2p, gt2p = _modulation(c_ctx, w_mod[l], b_mod[l])
        sh1s, sc1s, gt1s, sh2s, sc2s, gt2s = _modulation(c, w_mod[l], b_mod[l])
        hp = _rmsnorm(xp, norm_g[l, 0]) * (1.0 + sc1p) + sh1p
        hs = _rmsnorm(xs, norm_g[l, 0]) * (1.0 + sc1s) + sh1s
        if l % 2 == 0:
            e = l // 2
            qa, ka, va, qb, kb, vb, gb = _even_project(hp, w_in_even[e])
            oa = _attend_context(qa, ka, va)
            zero_ret = jnp.zeros((bp, 2, N_HEADS_B, HEAD_DIM, HEAD_DIM), F32)
            ob, s_ret = _retention_bidir(qb, kb, vb, gb, ret_decay[e], zero_ret)
            mp = jnp.concatenate([_merge(oa), _merge(ob)], axis=-1) @ w_out_even[e]
            kv_states.append(jnp.stack([ka, va], axis=1))
            ret_states.append(s_ret)
            qa, ka, va, qb, kb, vb, gb = _even_project(hs, w_in_even[e])
            oa = _neighbourhood_attend(qa, ka, va, cache_kv[:, e, 0], cache_kv[:, e, 1], rpb[e])
            ob, _ = _retention_bidir(_axial_rope(qb), _axial_rope(kb), vb, gb, ret_decay[e], state_ret[:, e])
            ms = jnp.concatenate([_merge(oa), _merge(ob)], axis=-1) @ w_out_even[e]
        else:
            o_i = l // 2
            zero_hg = jnp.zeros((bp, 2, N_HEADS_C, DK_C, DV_C), F32)
            mp, s_hg = _hgrn_bidir(hp, w_in_odd[o_i], w_out_odd[o_i], lower[o_i], hgrn_gnorm[o_i], zero_hg)
            hg_states.append(s_hg)
            ms, _ = _hgrn_bidir(hs, w_in_odd[o_i], w_out_odd[o_i], lower[o_i], hgrn_gnorm[o_i], state_hgrn[:, o_i])
        xp = xp + gt1p * _rmsnorm(mp, norm_g[l, 1])
        xs = xs + gt1s * _rmsnorm(ms, norm_g[l, 1])
        hp = _rmsnorm(xp, norm_g[l, 2]) * (1.0 + sc2p) + sh2p
        hs = _rmsnorm(xs, norm_g[l, 2]) * (1.0 + sc2s) + sh2s
        xp = xp + gt2p * _rmsnorm(_swiglu(hp, w_ffn_in[l], w_ffn_out[l]), norm_g[l, 3])
        xs = xs + gt2s * _rmsnorm(_swiglu(hs, w_ffn_in[l], w_ffn_out[l]), norm_g[l, 3])
    new_cache_kv = jnp.stack(kv_states, axis=1).astype(x_prompt.dtype)
    new_state_ret = jnp.stack(ret_states, axis=1).astype(x_prompt.dtype)
    new_state_hgrn = jnp.stack(hg_states, axis=1).astype(x_prompt.dtype)
    return (xp, xs, new_cache_kv, new_state_ret, new_state_hgrn)
```

```cpp
#include <hip/hip_runtime.h>
#include <cstdio>
#include <cstdint>
#include <cmath>
#ifndef MK_PER_PHASE
#define MK_PER_PHASE 0
#endif
namespace pg8 {
#define PG8_LAS __attribute__((address_space(3)))
typedef unsigned short bf16_t;
typedef short bf16x8 __attribute__((ext_vector_type(8)));
typedef float f32x4 __attribute__((ext_vector_type(4)));
typedef unsigned u32x4 __attribute__((ext_vector_type(4)));
constexpr int BM = 256, BK = 64, HALF = 128, HTB = HALF * BK * 2  , STAGE_BYTES = 8 * HTB, NXCD = 8, WGM = 8;

__host__ __device__ __forceinline__ int lds_byte(int r, int c) { const int st = (r >> 4) * 2 + (c >> 5), rr = r & 15, cc = c & 31, ob = rr * 64 + cc * 2; return st * 1024 + (ob ^ (((ob >> 9) & 1) << 5)); }
__host__ __device__ __forceinline__ void stage_rc(int b, int& R, int& C) { const int st = b / 1024, sb = b % 1024, swz = sb ^ (((sb >> 9) & 1) << 5); R = (st >> 1) * 16 + swz / 64; C = (st & 1) * 32 + (swz % 64) / 2; }
__host__ __device__ __forceinline__ int perm32(int rho) { const int n = rho >> 4, i = rho & 15; return 8 * (i >> 2) + 4 * n + (i & 3); }

struct Unit { int pm, pn; };
struct Gemm { const bf16_t* A; const bf16_t* Bt; int M, N, K; };

struct StaticOrder {
    int nM, nN, nwg, G, c;
    __host__ __device__ void init(int M, int N, int G_, int c_) { nM = M / BM; nN = N / BM; nwg = nM * nN; G = G_; c = c_; }
    __host__ __device__ bool next(int i, Unit& u) const {
        const long L = (long)i * G + c; if (L >= nwg) return false;
        int wgid = (int)L; { const int q = nwg / NXCD, r = nwg % NXCD, xcd = wgid % NXCD, off = wgid / NXCD; wgid = (xcd < r ? xcd * (q + 1) : r * (q + 1) + (xcd - r) * q) + off; }
        const int nig = WGM * nN, gid = wgid / nig, fm = gid * WGM, gsz = (nM - fm) < WGM ? (nM - fm) : WGM;
        u.pm = fm + ((wgid % nig) % gsz); u.pn = (wgid % nig) / gsz; return true;
    }
    __device__ __forceinline__ void a_ready(const Unit&) const {}
    __device__ __forceinline__ void done(const Unit&) const {}
};

__device__ __forceinline__ unsigned cvt_pk_bf16(float lo, float hi) { unsigned r; asm volatile("v_cvt_pk_bf16_f32 %0, %1, %2" : "=v"(r) : "v"(lo), "v"(hi)); return r; }
typedef unsigned u32x2e __attribute__((ext_vector_type(2)));
__device__ __forceinline__ float silu_f(float a) { return a * __builtin_amdgcn_rcpf(1.0f + __expf(-a)); }
struct EpiZ {
    static constexpr bool PERM = true, AFTER_DRAIN = false;
    bf16_t* O; int ldc; float* kv; int e;
    __device__ __forceinline__ void operator()(const f32x4 (&acc)[2][2][4][2], const Unit& u, int wr, int wc, int fr, int fq) const {
        const int row0 = u.pm * BM + wr * 64 + fr, col0 = u.pn * BM + wc * 32 + 8 * fq;
        const bool do_kv = (kv != nullptr) && (u.pm < 32) && (u.pn >= 2) && (u.pn < 6);
#pragma unroll
        for (int ai = 0; ai < 2; ++ai)
#pragma unroll
            for (int m = 0; m < 4; ++m) { const int row = row0 + ai * HALF + m * 16; bf16_t* rowp = O + (size_t)row * ldc + col0;
#pragma unroll
                for (int bj = 0; bj < 2; ++bj) { const f32x4 v0 = acc[ai][bj][m][0], v1 = acc[ai][bj][m][1];
                    u32x4 w; w.x = cvt_pk_bf16(v0[0], v0[1]); w.y = cvt_pk_bf16(v0[2], v0[3]); w.z = cvt_pk_bf16(v1[0], v1[1]); w.w = cvt_pk_bf16(v1[2], v1[3]);
                    *(u32x4*)(rowp + bj * HALF) = w;
                    if (do_kv) { const int c = col0 + bj * HALF - 512, kvi = c >> 9, hh = (c & 511) >> 6, d = c & 63, b = row >> 8, t = row & 255;
                        float* p = kv + ((((size_t)(b * 2 + e) * 2 + kvi) * 8 + hh) * 256 + t) * 64 + d;
                        *(f32x4*)p = v0; *(f32x4*)(p + 4) = v1; } } }
    }
};
struct EpiF32 {
    static constexpr bool PERM = false, AFTER_DRAIN = false;
    float* O; int ldc;
    __device__ __forceinline__ void operator()(const f32x4 (&acc)[2][2][4][2], const Unit& u, int wr, int wc, int fr, int fq) const {
        const int row0 = u.pm * BM + wr * 64 + fr, col0 = u.pn * BM + wc * 32 + 4 * fq;
#pragma unroll
        for (int ai = 0; ai < 2; ++ai)
#pragma unroll
            for (int m = 0; m < 4; ++m) { float* rowp = O + (size_t)(row0 + ai * HALF + m * 16) * ldc + col0;
#pragma unroll
                for (int bj = 0; bj < 2; ++bj)
#pragma unroll
                    for (int n = 0; n < 2; ++n) *(f32x4*)(rowp + bj * HALF + n * 16) = acc[ai][bj][m][n]; }
    }
};
struct EpiSwiglu {
    static constexpr bool PERM = true, AFTER_DRAIN = false;
    bf16_t* O; int ldc;
    __device__ __forceinline__ void operator()(const f32x4 (&acc)[2][2][4][2], const Unit& u, int wr, int wc, int fr, int fq) const {
        const int row0 = u.pm * BM + wr * 64 + fr, col0 = u.pn * HALF + wc * 32 + 8 * fq;
#pragma unroll
        for (int ai = 0; ai < 2; ++ai)
#pragma unroll
            for (int m = 0; m < 4; ++m) { bf16_t* rowp = O + (size_t)(row0 + ai * HALF + m * 16) * ldc + col0;
                const f32x4 a0 = acc[ai][0][m][0], a1 = acc[ai][0][m][1], u0 = acc[ai][1][m][0], u1 = acc[ai][1][m][1];
                u32x4 w;
                w.x = cvt_pk_bf16(silu_f(a0[0]) * u0[0], silu_f(a0[1]) * u0[1]); w.y = cvt_pk_bf16(silu_f(a0[2]) * u0[2], silu_f(a0[3]) * u0[3]);
                w.z = cvt_pk_bf16(silu_f(a1[0]) * u1[0], silu_f(a1[1]) * u1[1]); w.w = cvt_pk_bf16(silu_f(a1[2]) * u1[2], silu_f(a1[3]) * u1[3]);
                *(u32x4*)rowp = w; }
    }
};
template <class Epi, class Sched, bool ALIGN_EPI = false, bool SP2 = false>
__device__ __forceinline__ void gemm_phase(PG8_LAS unsigned char* lds, const Gemm g, const Sched& S, const Epi& E) {
    int tid_ = threadIdx.x; asm volatile("" : "+v"(tid_)); const int tid = tid_, wid = __builtin_amdgcn_readfirstlane(tid >> 6), lane = tid & 63, wr = wid >> 2, wc = wid & 3, fr = lane & 15, fq = lane >> 4;
    const int K = g.K, nt = K / BK;
    unsigned voffA[2], voffB[2];
#pragma unroll
    for (int i = 0; i < 2; ++i) { int R, C; stage_rc(tid * 16 + i * 8192, R, C); const int Rb = Epi::PERM ? ((R & ~31) + perm32(R & 31)) : R;
        voffA[i] = (unsigned)(R * K + C) * 2u; voffB[i] = (unsigned)(Rb * K + C) * 2u; }
    const size_t kstep = (size_t)(BK * 2);
    const size_t hstep = (size_t)HALF * K * 2;
    const size_t tstep = 2 * hstep;
    const unsigned ldsw = (unsigned)wid * 1024u;
    const int aoff = lds_byte(wr * 64 + fr, fq * 8), boff = lds_byte(wc * 32 + fr, fq * 8);
#define PG8_SA(b, h) (((b) * 2 + (h)) * HTB)
#define PG8_SB(b, h) ((4 + (b) * 2 + (h)) * HTB)
#define PG8_STAGE(bufoff, gbase, voff) do { _Pragma("unroll") for (int _i = 0; _i < 2; ++_i) \
        __builtin_amdgcn_global_load_lds((const unsigned*)((const char*)(gbase) + (voff)[_i]), (PG8_LAS unsigned*)(lds + (bufoff) + ldsw + _i * 8192), 16, 0, 0); } while (0)
#define PG8_LDA(dst, b, h) do { _Pragma("unroll") for (int m = 0; m < 4; ++m) _Pragma("unroll") for (int k = 0; k < 2; ++k) dst[m][k] = *(const PG8_LAS bf16x8*)(lds + PG8_SA(b, h) + aoff + m * 2048 + k * 1024); } while (0)
#define PG8_LDB(dst, b, h) do { _Pragma("unroll") for (int n = 0; n < 2; ++n) _Pragma("unroll") for (int k = 0; k < 2; ++k) dst[n][k] = *(const PG8_LAS bf16x8*)(lds + PG8_SB(b, h) + boff + n * 2048 + k * 1024); } while (0)
#define PG8_MMA(ai, bj, At, Bt) do { __builtin_amdgcn_s_setprio(1); _Pragma("unroll") for (int m = 0; m < 4; ++m) _Pragma("unroll") for (int n = 0; n < 2; ++n) _Pragma("unroll") for (int k = 0; k < 2; ++k) \
        acc[ai][bj][m][n] = __builtin_amdgcn_mfma_f32_16x16x32_bf16(Bt[n][k], At[m][k], acc[ai][bj][m][n], 0, 0, 0); __builtin_amdgcn_s_setprio(0); } while (0)
#define PG8_WAIT_V(n) asm volatile("s_waitcnt vmcnt(" #n ")" ::: "memory")
#define PG8_WAIT_L(n) asm volatile("s_waitcnt lgkmcnt(" #n ")" ::: "memory")
#define PG8_BAR __builtin_amdgcn_s_barrier()
#define PG8_SCHED __builtin_amdgcn_sched_barrier(0)
    Unit cur, nxt; int ui = 0;
    if (!S.next(0, cur)) return;
    f32x4 acc[2][2][4][2];
#pragma unroll
    for (int a = 0; a < 2; ++a)
#pragma unroll
        for (int b = 0; b < 2; ++b)
#pragma unroll
            for (int m = 0; m < 4; ++m)
#pragma unroll
                for (int n = 0; n < 2; ++n) acc[a][b][m][n] = (f32x4){0.f, 0.f, 0.f, 0.f};
    bf16x8 At[4][2], B0[2][2], B1[2][2];
    const char* cA = (const char*)g.A + (size_t)cur.pm * tstep; const char* cB = (const char*)g.Bt + (size_t)cur.pn * tstep;
    S.a_ready(cur);
    if constexpr (SP2) {
        PG8_STAGE(PG8_SB(0, 0), cB, voffB); PG8_STAGE(PG8_SB(0, 1), cB + hstep, voffB); PG8_STAGE(PG8_SA(0, 0), cA, voffA); PG8_STAGE(PG8_SA(0, 1), cA + hstep, voffA);
        if (wr == 1) PG8_BAR;
        PG8_WAIT_V(2); PG8_BAR;
        PG8_STAGE(PG8_SB(1, 0), cB + kstep, voffB); PG8_STAGE(PG8_SA(1, 0), cA + kstep, voffA); PG8_STAGE(PG8_SB(1, 1), cB + hstep + kstep, voffB);
        PG8_WAIT_V(6); PG8_BAR;
    } else {
        PG8_STAGE(PG8_SB(0, 0), cB, voffB); PG8_STAGE(PG8_SA(0, 0), cA, voffA); PG8_STAGE(PG8_SB(0, 1), cB + hstep, voffB); PG8_STAGE(PG8_SA(0, 1), cA + hstep, voffA);
        if (wr == 1) PG8_BAR;
        PG8_WAIT_V(4); PG8_BAR;
        PG8_STAGE(PG8_SB(1, 0), cB + kstep, voffB); PG8_STAGE(PG8_SA(1, 0), cA + kstep, voffA); PG8_STAGE(PG8_SB(1, 1), cB + hstep + kstep, voffB);
        PG8_WAIT_V(6); PG8_BAR;
    }
    for (;;) {
        const bool has_next = S.next(ui + 1, nxt);
        const char* nA = has_next ? (const char*)g.A + (size_t)nxt.pm * tstep : cA; const char* nB = has_next ? (const char*)g.Bt + (size_t)nxt.pn * tstep : cB;
        for (int t = 0; t < nt; t += 2) {
            const bool last = (t == nt - 2);
            const char* a1 = cA + (size_t)(t + 1) * kstep;
            const char* a2 = last ? nA : cA + (size_t)(t + 2) * kstep; const char* b2 = last ? nB : cB + (size_t)(t + 2) * kstep;
            const char* a3 = a2 + kstep; const char* b3 = b2 + kstep;
            if (last && has_next) S.a_ready(nxt);
            if constexpr (SP2) {
            PG8_LDB(B0, 0, 0); PG8_LDB(B1, 0, 1); PG8_SCHED; PG8_LDA(At, 0, 0); PG8_STAGE(PG8_SA(1, 1), a1 + hstep, voffA);
            PG8_WAIT_V(8); PG8_WAIT_L(0); PG8_BAR; PG8_MMA(0, 0, At, B0); PG8_MMA(0, 1, At, B1); PG8_BAR; PG8_SCHED;
            PG8_LDA(At, 0, 1); PG8_STAGE(PG8_SB(0, 0), b2, voffB); PG8_STAGE(PG8_SB(0, 1), b2 + hstep, voffB); PG8_STAGE(PG8_SA(0, 0), a2, voffA);
            PG8_WAIT_V(8); PG8_WAIT_L(0); PG8_BAR; PG8_MMA(1, 0, At, B0); PG8_MMA(1, 1, At, B1); PG8_BAR; PG8_SCHED;
            PG8_LDB(B0, 1, 0); PG8_LDB(B1, 1, 1); PG8_SCHED; PG8_LDA(At, 1, 0); PG8_STAGE(PG8_SA(0, 1), a2 + hstep, voffA);
            PG8_WAIT_V(8); PG8_WAIT_L(0); PG8_BAR; PG8_MMA(0, 0, At, B0); PG8_MMA(0, 1, At, B1); PG8_BAR; PG8_SCHED;
            PG8_LDA(At, 1, 1); PG8_STAGE(PG8_SB(1, 0), b3, voffB); PG8_STAGE(PG8_SB(1, 1), b3 + hstep, voffB); PG8_STAGE(PG8_SA(1, 0), a3, voffA);
            PG8_WAIT_V(8); PG8_WAIT_L(0); PG8_BAR; PG8_MMA(1, 0, At, B0); PG8_MMA(1, 1, At, B1); PG8_BAR; PG8_SCHED;
            } else {
            PG8_LDB(B0, 0, 0); PG8_SCHED; PG8_LDA(At, 0, 0); PG8_STAGE(PG8_SA(1, 1), a1 + hstep, voffA);
            PG8_WAIT_L(8); PG8_BAR; PG8_WAIT_L(0); PG8_MMA(0, 0, At, B0); PG8_BAR; PG8_SCHED;
            PG8_LDB(B1, 0, 1); PG8_STAGE(PG8_SB(0, 0), b2, voffB);
            PG8_BAR; PG8_WAIT_L(0); PG8_MMA(0, 1, At, B1); PG8_BAR;
            PG8_LDA(At, 0, 1); PG8_STAGE(PG8_SA(0, 0), a2, voffA);
            PG8_BAR; PG8_WAIT_L(0); PG8_MMA(1, 0, At, B0); PG8_BAR; PG8_SCHED;
            PG8_STAGE(PG8_SB(0, 1), b2 + hstep, voffB);
            PG8_WAIT_V(6); PG8_BAR; PG8_MMA(1, 1, At, B1); PG8_BAR;
            PG8_LDB(B0, 1, 0); PG8_SCHED; PG8_LDA(At, 1, 0); PG8_STAGE(PG8_SA(0, 1), a2 + hstep, voffA);
            PG8_WAIT_L(8); PG8_BAR; PG8_WAIT_L(0); PG8_MMA(0, 0, At, B0); PG8_BAR; PG8_SCHED;
            PG8_LDB(B1, 1, 1); PG8_STAGE(PG8_SB(1, 0), b3, voffB);
            PG8_BAR; PG8_WAIT_L(0); PG8_MMA(0, 1, At, B1); PG8_BAR;
            PG8_LDA(At, 1, 1); PG8_STAGE(PG8_SA(1, 0), a3, voffA);
            PG8_BAR; PG8_WAIT_L(0); PG8_MMA(1, 0, At, B0); PG8_BAR; PG8_SCHED;
            PG8_STAGE(PG8_SB(1, 1), b3 + hstep, voffB);
            PG8_WAIT_V(6); PG8_BAR; PG8_MMA(1, 1, At, B1); PG8_BAR;
            }
        }
        if constexpr (ALIGN_EPI) { if (wr == 0) PG8_BAR; }
        if constexpr (!Epi::AFTER_DRAIN) { E(acc, cur, wr, wc, fr, fq); S.done(cur); }
        if (!has_next) break;
#pragma unroll
        for (int a = 0; a < 2; ++a)
#pragma unroll
            for (int b = 0; b < 2; ++b)
#pragma unroll
                for (int m = 0; m < 4; ++m)
#pragma unroll
                    for (int n = 0; n < 2; ++n) acc[a][b][m][n] = (f32x4){0.f, 0.f, 0.f, 0.f};
        cur = nxt; cA = nA; cB = nB; ++ui;
        if constexpr (ALIGN_EPI) { if (wr == 1) PG8_BAR; }
    }
    PG8_WAIT_V(0);
    if constexpr (!ALIGN_EPI) { if (wr == 0) PG8_BAR; }
    PG8_BAR;
    if constexpr (Epi::AFTER_DRAIN) { E.fused(acc, cur, wr, wc, fr, fq, lds, wid, lane); S.done(cur); }
#undef PG8_SA
#undef PG8_SB
#undef PG8_STAGE
#undef PG8_LDA
#undef PG8_LDB
#undef PG8_MMA
#undef PG8_WAIT_V
#undef PG8_WAIT_L
#undef PG8_BAR
#undef PG8_SCHED
}
}
#define GAS __attribute__((address_space(1)))
#define LAS __attribute__((address_space(3)))
typedef unsigned short bf16;
typedef unsigned v4u __attribute__((ext_vector_type(4)));
typedef float f32x4 __attribute__((ext_vector_type(4)));
typedef short bf16x8 __attribute__((ext_vector_type(8)));
typedef GAS unsigned gu32;
typedef GAS unsigned long long gu64;
#define RLX_AGENT __ATOMIC_RELAXED, __HIP_MEMORY_SCOPE_AGENT
#define LDS_WAIT() asm volatile("s_waitcnt lgkmcnt(0)" ::: "memory")
#define VM_WAIT() asm volatile("s_waitcnt vmcnt(0)" ::: "memory")
__device__ __forceinline__ unsigned long long rt() { return __builtin_amdgcn_s_memrealtime(); }
__device__ __forceinline__ unsigned f2bf(float f) { unsigned u = __builtin_bit_cast(unsigned, f); return (u + 0x7fffu + ((u >> 16) & 1u)) >> 16; }
__device__ __forceinline__ unsigned pk2(float lo, float hi) { return f2bf(lo) | (f2bf(hi) << 16); }
#define XB_TMO      128
#define XB_XCNT(j)  (256  + 64 * (j))
#define XB_XSUB(j)  (1280 + 64 * (j))
#define XB_XGEN(j)  (2304 + 64 * (j))
#define XB_TOP      3328
#define XB_TOPGEN   3392
#define XCD_BAR_WORDS 3456
#define XB_SPIN_CAP (1u << 18)

__device__ __forceinline__ unsigned xb_ld(unsigned* p)              { return __hip_atomic_load(p, __ATOMIC_RELAXED, __HIP_MEMORY_SCOPE_AGENT); }
__device__ __forceinline__ unsigned xb_add(unsigned* p, unsigned v) { return __hip_atomic_fetch_add(p, v, __ATOMIC_RELAXED, __HIP_MEMORY_SCOPE_AGENT); }
__device__ __forceinline__ unsigned xb_xcc_id() { return (unsigned)__builtin_amdgcn_s_getreg((3 << 11) | 20) & 0xFu; }
#define XB_SPIN(cond, bar) do { unsigned _sp = 0; while (cond) { __builtin_amdgcn_s_sleep(1); \
    if ((++_sp & 255u) == 0u) { if (xb_ld(&(bar)[XB_TMO])) break; if (_sp > XB_SPIN_CAP) { atomicAdd(&(bar)[XB_TMO], 1u); break; } } } } while (0)

struct XcdBarrier {
    unsigned* bar; unsigned x;
    volatile LAS unsigned* st;
};

__device__ __forceinline__ XcdBarrier xcd_barrier_post(unsigned* bar, volatile LAS unsigned* st) {
    XcdBarrier b; b.bar = bar; b.x = xb_xcc_id(); b.st = st;
    if (threadIdx.x == 0) (void)xb_add(&bar[XB_XCNT(b.x)], 1u);
    return b;
}
__device__ __forceinline__ void xcd_barrier_complete(unsigned* bar, unsigned x, unsigned& nloc, unsigned& nx) {
    const unsigned G = gridDim.x * gridDim.y * gridDim.z;
    unsigned sum, cnt, mine, sp = 0u;
    for (;;) {
        sum = 0u; cnt = 0u; mine = 0u;
#pragma unroll
        for (unsigned j = 0; j < 16; ++j) { const unsigned c = xb_ld(&bar[XB_XCNT(j)]); sum += c; cnt += (c > 0u) ? 1u : 0u; mine = (j == x) ? c : mine; }
        if (sum == G) break;
        __builtin_amdgcn_s_sleep(1);
        if ((++sp & 255u) == 0u) { if (xb_ld(&bar[XB_TMO])) break; if (sp > XB_SPIN_CAP) { atomicAdd(&bar[XB_TMO], 1u); break; } }
    }
    nloc = mine > 0u ? mine : 1u; nx = cnt > 0u ? cnt : 1u;
}

__device__ __forceinline__ void xcd_barrier(const XcdBarrier& b) {
    asm volatile("s_waitcnt vmcnt(0)" ::: "memory");
    __syncthreads();
    if (threadIdx.x == 0) {
        unsigned* bar = b.bar;
        __builtin_amdgcn_s_waitcnt(0);
        unsigned nloc = b.st[0], nx = b.st[1];
        if (nloc == 0u) { xcd_barrier_complete(bar, b.x, nloc, nx); b.st[0] = nloc; b.st[1] = nx; }
        const unsigned old = xb_add(&bar[XB_XSUB(b.x)], 1u);
        const unsigned gen = old / nloc;
        if (old + 1u == (gen + 1u) * nloc) {
            __builtin_amdgcn_fence(__ATOMIC_RELEASE, "agent");
            asm volatile("s_waitcnt vmcnt(0)" ::: "memory");
            const unsigned og = xb_add(&bar[XB_TOP], 1u);
            const unsigned tg = og / nx;
            if (og + 1u == (tg + 1u) * nx) xb_add(&bar[XB_TOPGEN], 1u);
            else XB_SPIN(xb_ld(&bar[XB_TOPGEN]) == tg, bar);
            __builtin_amdgcn_fence(__ATOMIC_ACQUIRE, "agent");
            xb_add(&bar[XB_XGEN(b.x)], 1u);
            asm volatile("s_waitcnt vmcnt(0)" ::: "memory");
        } else {
            XB_SPIN(xb_ld(&bar[XB_XGEN(b.x)]) == gen, bar);
            __builtin_amdgcn_fence(__ATOMIC_ACQUIRE, "agent");
            asm volatile("s_waitcnt vmcnt(0)" ::: "memory");
        }
    }
    __syncthreads();
}
constexpr int NWAVES = 8, NTHREADS = 512;
constexpr int DM = 1024, MROWS = 16384, MP = 8192;
constexpr int NE_IN = 3584, NO_IN = 5120, DFF = 2816, NFF_IN = 5632;
constexpr float EPS_N = 1e-6f;
constexpr size_t OUT_KV = 16777216, OUT_SR = 33554432, OUT_SH = 37748736;
constexpr size_t MiB = 1u << 20;
constexpr size_t WS_CTL = 0, WS_MOD = 1 * MiB, CTL_ZERO_BYTES = 2 * MiB;
constexpr size_t WS_LOWER = 2 * MiB;
constexpr size_t WS_WTE_IN = 3 * MiB, WS_WTE_OUT = 17 * MiB, WS_WTO_IN = 21 * MiB, WS_WTO_OUT = 41 * MiB, WS_WTF_IN = 45 * MiB, WS_WTF_OUT = 89 * MiB;
constexpr size_t WS_H = 111 * MiB;
constexpr size_t WS_Z = 143 * MiB;
constexpr size_t WS_M = 303 * MiB;
constexpr size_t WS_END = 367 * MiB;
constexpr int CW_BAR = 4096;

constexpr int RING_BYTES = 131072, LDSCTL_OFF = RING_BYTES, MISC_OFF = LDSCTL_OFF + 320, LDS_BYTES = 147456;

__device__ __forceinline__ float bf2f(unsigned short b) { return __uint_as_float((unsigned)b << 16); }
__device__ __forceinline__ void unpack8(const v4u w, float (&f)[8]) {
    f[0] = __uint_as_float(w.x << 16); f[1] = __uint_as_float(w.x & 0xffff0000u); f[2] = __uint_as_float(w.y << 16); f[3] = __uint_as_float(w.y & 0xffff0000u);
    f[4] = __uint_as_float(w.z << 16); f[5] = __uint_as_float(w.z & 0xffff0000u); f[6] = __uint_as_float(w.w << 16); f[7] = __uint_as_float(w.w & 0xffff0000u);
}
__device__ __forceinline__ unsigned short f2bf16(float f) { return (unsigned short)f2bf(f); }
__device__ __forceinline__ float wave_sum(float v) {
#pragma unroll
    for (int o = 1; o < 64; o <<= 1) v += __shfl_xor(v, o);
    return v;
}
__device__ __forceinline__ float sigmoid_f(float x) { return 1.0f / (1.0f + __expf(-x)); }

struct Args { const float* in[20]; float* out; unsigned char* ws; int ph_lo, ph_hi; };
struct Ctx {
    LAS unsigned char* lds;
    __device__ __forceinline__ unsigned long long rd(int i) const { volatile LAS unsigned long long* t = (volatile LAS unsigned long long*)(lds + LDSCTL_OFF); const unsigned long long v = t[i];
        const unsigned lo = __builtin_amdgcn_readfirstlane((unsigned)v), hi = __builtin_amdgcn_readfirstlane((unsigned)(v >> 32)); return ((unsigned long long)hi << 32) | lo; }
    __device__ __forceinline__ const float* in(int i) const { return (const float*)rd(i); }
    __device__ __forceinline__ float* out() const { return (float*)rd(20); }
    __device__ __forceinline__ unsigned char* ws() const { return (unsigned char*)rd(21); }
};

template <bool FFN>
__device__ __forceinline__ void transpose_item(const float* W, int K, int N, bf16* WT, LAS float* scr, int item, int lane) {
    const int nblk = N / 32, kb = item / nblk, nb = item % nblk, k0 = 64 * kb, n0d = 32 * nb;
    int n0s = n0d;
    if (FFN) { const int tile = n0d >> 8, within = n0d & 255; n0s = (within < 128) ? tile * 128 + within : DFF + tile * 128 + (within - 128); }
#pragma unroll 8
    for (int i = 0; i < 32; ++i) { const int kk = 2 * i + (lane >> 5); scr[kk * 33 + (lane & 31)] = W[(size_t)(k0 + kk) * N + n0s + (lane & 31)]; }
    LDS_WAIT(); asm volatile("" ::: "memory");
    const int c = lane & 7;
#pragma unroll
    for (int j = 0; j < 4; ++j) { const int n = (lane >> 3) + 8 * j; const LAS float* s = scr + (8 * c) * 33 + n;
        v4u o; o.x = pk2(s[0 * 33], s[1 * 33]); o.y = pk2(s[2 * 33], s[3 * 33]); o.z = pk2(s[4 * 33], s[5 * 33]); o.w = pk2(s[6 * 33], s[7 * 33]);
        *(GAS v4u*)(WT + (size_t)(n0d + n) * K + k0 + 8 * c) = o; }
    LDS_WAIT(); asm volatile("" ::: "memory");
}

__device__ __forceinline__ void phase_p0(const Ctx& a, LAS unsigned char* lds, int tid, int lane, int wave, int bid, int G) {
    LAS float* sc = (LAS float*)lds;
    { const float* cctx = a.in(6); const float* cc = a.in(5);
      for (int i = tid; i < 9 * 1024; i += NTHREADS) { const int r = i >> 10, k = i & 1023; const float v = (r == 0) ? cctx[k] : cc[(r - 1) * 1024 + k]; sc[i] = v * sigmoid_f(v); } }
    __syncthreads();
    LAS float* red = (LAS float*)(lds + 40960);
    float* MOD = (float*)(a.ws() + WS_MOD); const float* wm = a.in(7); const float* bm = a.in(8);
    for (int u = bid; u < 384; u += G) {
        const int l = u / 96, nb = u % 96;
        const int col = tid & 63, ks = tid >> 6, n = nb * 64 + col, k0 = ks * 128;
        const float* w = wm + ((size_t)l * 1024 + k0) * 6144 + n;
        float acc[9];
#pragma unroll
        for (int r = 0; r < 9; ++r) acc[r] = 0.f;
#pragma unroll 4
        for (int k = 0; k < 128; ++k) { const float wv = w[(size_t)k * 6144];
#pragma unroll
            for (int r = 0; r < 9; ++r) acc[r] += sc[r * 1024 + k0 + k] * wv; }
#pragma unroll
        for (int r = 0; r < 9; ++r) red[(ks * 64 + col) * 9 + r] = acc[r];
        __syncthreads();
        for (int o = tid; o < 576; o += NTHREADS) { const int c = o / 9, r = o % 9; float sum = bm[l * 6144 + nb * 64 + c];
#pragma unroll
            for (int q = 0; q < 8; ++q) sum += red[(q * 64 + c) * 9 + r];
            MOD[((size_t)l * 9 + r) * 6144 + nb * 64 + c] = sum; }
        __syncthreads();
    }
    { float* LOWER = (float*)(a.ws() + WS_LOWER); const float* hlb = a.in(16);
      for (int idx = bid * NTHREADS + tid; idx < 2048; idx += G * NTHREADS) {
          const float x0 = hlb[idx], x1 = hlb[2048 + idx], mx = fmaxf(x0, x1), e0 = expf(x0 - mx), e1 = expf(x1 - mx), s = e0 + e1, p0 = e0 / s, p1 = e1 / s;
          LOWER[idx] = fminf(fmaxf(p0 - p0, 0.f), 1.f); LOWER[2048 + idx] = fminf(fmaxf((p0 + p1) - p0, 0.f), 1.f); } }
    __syncthreads();
    LAS float* scr = (LAS float*)(lds + wave * 16384);
    const int gw = bid * NWAVES + wave, NGW = G * NWAVES;
    for (int it = gw; it < 27648; it += NGW) {
        int r = it;
        if (r < 3584) { const int e = r / 1792; transpose_item<false>(a.in(10) + (size_t)e * 1024 * NE_IN, 1024, NE_IN, (bf16*)(a.ws() + WS_WTE_IN) + (size_t)e * NE_IN * 1024, scr, r % 1792, lane); continue; } r -= 3584;
        if (r < 1024) { const int e = r / 512; transpose_item<false>(a.in(11) + (size_t)e * 1048576, 1024, 1024, (bf16*)(a.ws() + WS_WTE_OUT) + (size_t)e * 1048576, scr, r % 512, lane); continue; } r -= 1024;
        if (r < 5120) { const int o = r / 2560; transpose_item<false>(a.in(14) + (size_t)o * 1024 * NO_IN, 1024, NO_IN, (bf16*)(a.ws() + WS_WTO_IN) + (size_t)o * NO_IN * 1024, scr, r % 2560, lane); continue; } r -= 5120;
        if (r < 1024) { const int o = r / 512; transpose_item<false>(a.in(15) + (size_t)o * 1048576, 1024, 1024, (bf16*)(a.ws() + WS_WTO_OUT) + (size_t)o * 1048576, scr, r % 512, lane); continue; } r -= 1024;
        if (r < 11264) { const int l = r / 2816; transpose_item<true>(a.in(18) + (size_t)l * 1024 * NFF_IN, 1024, NFF_IN, (bf16*)(a.ws() + WS_WTF_IN) + (size_t)l * NFF_IN * 1024, scr, r % 2816, lane); continue; } r -= 11264;
        { const int l = r / 1408; transpose_item<false>(a.in(19) + (size_t)l * DFF * 1024, DFF, 1024, (bf16*)(a.ws() + WS_WTF_OUT) + (size_t)l * 1024 * DFF, scr, r % 1408, lane); }
    }
}

__device__ __forceinline__ void phase_rowpass(const Ctx& a, int l, int mode, int lane, int gw, int NGW) {
    float* X = a.out(); const float* Mb = (const float*)(a.ws() + WS_M); bf16* H = (bf16*)(a.ws() + WS_H); const float* MOD = (const float*)(a.ws() + WS_MOD); const float* ng = a.in(9); const float* xin0 = a.in(0); const float* xin1 = a.in(1);
    const float* g_a = ng + (size_t)(l * 4 + (mode == 1 ? 1 : 3)) * 1024;
    const int gt_off = (mode == 1) ? 2048 : 5120;
    const int lh = (mode == 2) ? l + 1 : l;
    const bool doH = !(mode == 2 && l == 3);
    const float* g_b = ng + (size_t)((doH ? lh : 0) * 4 + (mode == 1 ? 2 : 0)) * 1024;
    const int sh_off = (mode == 1) ? 3072 : 0, sc_off = (mode == 1) ? 4096 : 1024;
    for (int row = gw; row < MROWS; row += NGW) {
        const int bidx = row < MP ? 0 : 1 + ((row - MP) >> 10);
        const float* modl = MOD + ((size_t)l * 9 + bidx) * 6144;
        const float* modh = MOD + ((size_t)(doH ? lh : 0) * 9 + bidx) * 6144;
        const float* xsrc = (mode == 0) ? (row < MP ? xin0 + (size_t)row * 1024 : xin1 + (size_t)(row - MP) * 1024) : X + (size_t)row * 1024;
        f32x4 xv[4];
#pragma unroll
        for (int j = 0; j < 4; ++j) xv[j] = *(const GAS f32x4*)(xsrc + lane * 4 + 256 * j);
        if (mode != 0) {
            f32x4 mv[4]; float ss = 0.f;
#pragma unroll
            for (int j = 0; j < 4; ++j) { mv[j] = *(const GAS f32x4*)(Mb + (size_t)row * 1024 + lane * 4 + 256 * j); ss += (mv[j].x * mv[j].x + mv[j].y * mv[j].y) + (mv[j].z * mv[j].z + mv[j].w * mv[j].w); }
            const float rstd = rsqrtf(wave_sum(ss) * (1.f / 1024.f) + EPS_N);
#pragma unroll
            for (int j = 0; j < 4; ++j) { const f32x4 ga = *(const GAS f32x4*)(g_a + lane * 4 + 256 * j), gt = *(const GAS f32x4*)(modl + gt_off + lane * 4 + 256 * j);
                xv[j] = xv[j] + gt * (mv[j] * rstd * ga); }
        }
#pragma unroll
        for (int j = 0; j < 4; ++j) *(GAS f32x4*)(X + (size_t)row * 1024 + lane * 4 + 256 * j) = xv[j];
        if (doH) {
            float ss = 0.f;
#pragma unroll
            for (int j = 0; j < 4; ++j) ss += (xv[j].x * xv[j].x + xv[j].y * xv[j].y) + (xv[j].z * xv[j].z + xv[j].w * xv[j].w);
            const float rstd = rsqrtf(wave_sum(ss) * (1.f / 1024.f) + EPS_N);
#pragma unroll
            for (int j = 0; j < 4; ++j) { const f32x4 gb = *(const GAS f32x4*)(g_b + lane * 4 + 256 * j), sc = *(const GAS f32x4*)(modh + sc_off + lane * 4 + 256 * j), sh = *(const GAS f32x4*)(modh + sh_off + lane * 4 + 256 * j);
                const f32x4 hv = xv[j] * rstd * gb * (sc + 1.0f) + sh;
                *(GAS unsigned long long*)(H + (size_t)row * 1024 + lane * 4 + 256 * j) = (unsigned long long)pk2(hv.x, hv.y) | ((unsigned long long)pk2(hv.z, hv.w) << 32); }
        }
    }
}

struct SoftAcc { float m, l; float o[64]; };
__device__ __forceinline__ void soft_init(SoftAcc& s) { s.m = -INFINITY; s.l = 0.f;
#pragma unroll
    for (int d = 0; d < 64; ++d) s.o[d] = 0.f; }
#define CFENCE() asm volatile("" ::: "memory")
struct RowLds  { const LAS float* p; __device__ __forceinline__ f32x4 operator()(int c) const { return *(const LAS f32x4*)(p + 4 * c); } };
struct RowGf32 { const float* p;     __device__ __forceinline__ f32x4 operator()(int c) const { return *(const GAS f32x4*)(p + 4 * c); } };
struct RowGbf  { const bf16* p;      __device__ __forceinline__ f32x4 operator()(int c) const { const unsigned long long w = *(const GAS unsigned long long*)(p + 4 * c); const unsigned lo = (unsigned)w, hi = (unsigned)(w >> 32);
    return (f32x4){__uint_as_float(lo << 16), __uint_as_float(lo & 0xffff0000u), __uint_as_float(hi << 16), __uint_as_float(hi & 0xffff0000u)}; } };
template <class R> __device__ __forceinline__ float dot64(const float (&q)[64], const R& r, float init) {
    float sc = init;
#pragma unroll
    for (int c = 0; c < 16; ++c) { const f32x4 k = r(c); sc += q[4 * c] * k.x; sc += q[4 * c + 1] * k.y; sc += q[4 * c + 2] * k.z; sc += q[4 * c + 3] * k.w; if ((c & 3) == 3) CFENCE(); }
    return sc;
}
template <class R> __device__ __forceinline__ void soft_upd(SoftAcc& s, float sc, const R& r) {
    const float mn = fmaxf(s.m, sc), al = __expf(s.m - mn), p = __expf(sc - mn);
    s.l = s.l * al + p; s.m = mn;
#pragma unroll
    for (int c = 0; c < 16; ++c) { const f32x4 v = r(c); s.o[4 * c] = s.o[4 * c] * al + p * v.x; s.o[4 * c + 1] = s.o[4 * c + 1] * al + p * v.y; s.o[4 * c + 2] = s.o[4 * c + 2] * al + p * v.z; s.o[4 * c + 3] = s.o[4 * c + 3] * al + p * v.w; if ((c & 3) == 3) CFENCE(); }
}
__device__ __forceinline__ void soft_store(const SoftAcc& s, LAS float* p) { p[0] = s.m; p[1] = s.l;
#pragma unroll
    for (int d = 0; d < 64; ++d) p[2 + d] = s.o[d]; }
__device__ __forceinline__ void soft_merge(SoftAcc& s, const LAS float* p) {
    const float m2 = p[0], l2 = p[1], mn = fmaxf(s.m, m2), a1 = __expf(s.m - mn), a2 = __expf(m2 - mn);
    s.l = s.l * a1 + l2 * a2; s.m = mn;
#pragma unroll
    for (int d = 0; d < 64; ++d) s.o[d] = s.o[d] * a1 + p[2 + d] * a2;
}
__device__ __forceinline__ void load_row64_bf16(const bf16* p, float (&f)[64]) {
#pragma unroll
    for (int c = 0; c < 8; ++c) { const v4u w = *(const GAS v4u*)(p + 8 * c); float t[8]; unpack8(w, t);
#pragma unroll
        for (int i = 0; i < 8; ++i) f[8 * c + i] = t[i]; }
}
__device__ __forceinline__ void store_row64_bf16(bf16* p, const float (&f)[64], float scale) {
#pragma unroll
    for (int c = 0; c < 8; ++c) { v4u w; w.x = pk2(f[8 * c] * scale, f[8 * c + 1] * scale); w.y = pk2(f[8 * c + 2] * scale, f[8 * c + 3] * scale); w.z = pk2(f[8 * c + 4] * scale, f[8 * c + 5] * scale); w.w = pk2(f[8 * c + 6] * scale, f[8 * c + 7] * scale);
        *(GAS v4u*)(p + 8 * c) = w; }
}

__device__ __forceinline__ void ctx_attn_unit(const Ctx& a, LAS unsigned char* lds, int tid, int b, int h) {
    const bf16* Z = (const bf16*)(a.ws() + WS_Z); bf16* O = (bf16*)(a.ws() + WS_H);
    LAS float* sK = (LAS float*)lds; LAS float* sV = sK + 256 * 64;
    const size_t rb = (size_t)b * 256;
    for (int t = 0; t < 4; ++t) { const int idx = tid + NTHREADS * t, key = idx >> 3, ch = idx & 7; const bf16* zr = Z + (rb + key) * NE_IN + h * 64 + ch * 8;
        float f[8]; unpack8(*(const GAS v4u*)(zr + 512), f);
        *(LAS f32x4*)(sK + key * 64 + ch * 8) = (f32x4){f[0], f[1], f[2], f[3]}; *(LAS f32x4*)(sK + key * 64 + ch * 8 + 4) = (f32x4){f[4], f[5], f[6], f[7]};
        unpack8(*(const GAS v4u*)(zr + 1024), f);
        *(LAS f32x4*)(sV + key * 64 + ch * 8) = (f32x4){f[0], f[1], f[2], f[3]}; *(LAS f32x4*)(sV + key * 64 + ch * 8 + 4) = (f32x4){f[4], f[5], f[6], f[7]}; }
    __syncthreads();
    const int q = tid & 255, half = tid >> 8;
    float qv[64]; load_row64_bf16(Z + (rb + q) * NE_IN + h * 64, qv);
#pragma unroll
    for (int d = 0; d < 64; ++d) qv[d] *= 0.125f;
    SoftAcc s; soft_init(s);
    for (int j = 0; j < 128; ++j) { const int key = half * 128 + j;
        const float sc = dot64(qv, RowLds{sK + key * 64}, 0.f);
        soft_upd(s, sc, RowLds{sV + key * 64}); }
    __syncthreads();
    LAS float* slot = (LAS float*)lds + q * 66;
    if (half == 1) soft_store(s, slot);
    __syncthreads();
    if (half == 0) { soft_merge(s, slot); store_row64_bf16(O + (rb + q) * 1024 + h * 64, s.o, 1.0f / s.l); }
    __syncthreads();
}

__device__ __forceinline__ void na_unit(const Ctx& a, LAS unsigned char* lds, int tid, int e, int b, int h, int r) {
    const bf16* Z = (const bf16*)(a.ws() + WS_Z); bf16* O = (bf16*)(a.ws() + WS_H);
    const int qc = tid & 63, p = tid >> 6;
    const size_t lb = (size_t)MP + (size_t)b * 1024;
    const int kr0 = min(max(r - 4, 0), 8), kr = kr0 + p, win0 = min(max(qc - 8, 0), 48);
    float qv[64]; load_row64_bf16(Z + (lb + r * 64 + qc) * NE_IN + h * 64, qv);
#pragma unroll
    for (int d = 0; d < 64; ++d) qv[d] *= 0.125f;
    const float* rp = a.in(12) + ((size_t)(e * 8 + h) * 15 + (kr - r + 7)) * 31;
    SoftAcc s; soft_init(s);
    for (int j = 0; j < 16; ++j) { const int kc = win0 + j; const bf16* zr = Z + (lb + kr * 64 + kc) * NE_IN + h * 64;
        const float sc = dot64(qv, RowGbf{zr + 512}, rp[kc - qc + 15]);
        soft_upd(s, sc, RowGbf{zr + 1024}); }
    const float* ck = a.in(2) + ((((size_t)(b * 2 + e) * 2 + 0) * 8 + h) * 256) * 64;
    const float* cv = a.in(2) + ((((size_t)(b * 2 + e) * 2 + 1) * 8 + h) * 256) * 64;
    for (int j = 0; j < 32; ++j) { const int kj = 32 * p + j;
        const float sc = dot64(qv, RowGf32{ck + (size_t)kj * 64}, 0.f);
        soft_upd(s, sc, RowGf32{cv + (size_t)kj * 64}); }
    LAS float* slots = (LAS float*)lds;
    if (p >= 4) soft_store(s, slots + ((p - 4) * 64 + qc) * 66);
    __syncthreads();
    if (p < 4) soft_merge(s, slots + (p * 64 + qc) * 66);
    __syncthreads();
    if (p == 2 || p == 3) soft_store(s, slots + ((p - 2) * 64 + qc) * 66);
    __syncthreads();
    if (p < 2) soft_merge(s, slots + (p * 64 + qc) * 66);
    __syncthreads();
    if (p == 1) soft_store(s, slots + qc * 66);
    __syncthreads();
    if (p == 0) { soft_merge(s, slots + qc * 66); store_row64_bf16(O + (lb + r * 64 + qc) * 1024 + h * 64, s.o, 1.0f / s.l); }
    __syncthreads();
}

__device__ __forceinline__ void ret_chain(const Ctx& a, LAS unsigned char* lds, int tid, int e, bool lat, int b, int h, int dir) {
    const bf16* Z = (const bf16*)(a.ws() + WS_Z); bf16* OFB = (bf16*)(a.ws() + WS_M + (dir ? 32 * MiB : 0));
    const int T = lat ? 1024 : 256; const size_t rowbase = lat ? (size_t)MP + (size_t)b * 1024 : (size_t)b * 256;
    const float g = expf(-expf(a.in(13)[(e * 2 + dir) * 8 + h]));
    const int v = tid & 63, dg = tid >> 6;
    float S[8]; const float* s0p = a.in(3);
#pragma unroll
    for (int i = 0; i < 8; ++i) S[i] = lat ? s0p[((((size_t)(b * 2 + e) * 2 + dir) * 8 + h) * 64 + dg * 8 + i) * 64 + v] : 0.f;
    LAS float* sq = (LAS float*)lds; LAS float* sk = sq + 32 * 64; LAS float* sv = sk + 32 * 64; LAS float* part = sv + 32 * 64;
    const int ltok = tid >> 4, li = tid & 15;
    const float inv = exp2f(-(float)li * (13.287712379549449f / 16.0f));
    for (int c0 = 0; c0 < T; c0 += 32) {
        { const int st = c0 + ltok, n = dir ? T - 1 - st : st; const bf16* zr = Z + (rowbase + n) * NE_IN + h * 64;
#pragma unroll
          for (int hf = 0; hf < 2; ++hf) {
              float q1 = bf2f(zr[1536 + hf * 32 + li]), q2 = bf2f(zr[1536 + hf * 32 + 16 + li]), k1 = bf2f(zr[2048 + hf * 32 + li]), k2 = bf2f(zr[2048 + hf * 32 + 16 + li]);
              if (lat) { const float pos = (float)(hf == 0 ? (n >> 6) : (n & 63)); float sn, cs; sincosf(pos * inv, &sn, &cs);
                  const float a1 = q1 * cs - q2 * sn, a2 = q1 * sn + q2 * cs, b1 = k1 * cs - k2 * sn, b2 = k1 * sn + k2 * cs; q1 = a1; q2 = a2; k1 = b1; k2 = b2; }
              sq[ltok * 64 + hf * 32 + li] = q1; sq[ltok * 64 + hf * 32 + 16 + li] = q2; sk[ltok * 64 + hf * 32 + li] = k1 * 0.125f; sk[ltok * 64 + hf * 32 + 16 + li] = k2 * 0.125f; }
#pragma unroll
          for (int j = 0; j < 4; ++j) sv[ltok * 64 + j * 16 + li] = bf2f(zr[2560 + j * 16 + li]); }
        __syncthreads();
        for (int j = 0; j < 32; ++j) {
            const float vv = sv[j * 64 + v];
            const f32x4 qa = *(const LAS f32x4*)(sq + j * 64 + dg * 8), qb = *(const LAS f32x4*)(sq + j * 64 + dg * 8 + 4), ka = *(const LAS f32x4*)(sk + j * 64 + dg * 8), kb = *(const LAS f32x4*)(sk + j * 64 + dg * 8 + 4);
            const float qq[8] = {qa.x, qa.y, qa.z, qa.w, qb.x, qb.y, qb.z, qb.w}, kk[8] = {ka.x, ka.y, ka.z, ka.w, kb.x, kb.y, kb.z, kb.w};
            float acc = 0.f;
#pragma unroll
            for (int i = 0; i < 8; ++i) { S[i] = g * S[i] + kk[i] * vv; acc += qq[i] * S[i]; }
            part[(j * 8 + dg) * 64 + v] = acc; }
        __syncthreads();
#pragma unroll
        for (int t = 0; t < 4; ++t) { const int idx = tid + NTHREADS * t, tok = idx >> 6, vv = idx & 63; float sum = 0.f;
#pragma unroll
            for (int d8 = 0; d8 < 8; ++d8) sum += part[(tok * 8 + d8) * 64 + vv];
            const int st = c0 + tok, n = dir ? T - 1 - st : st;
            OFB[(rowbase + n) * 1024 + h * 64 + vv] = f2bf16(sum); }
        __syncthreads();
    }
    if (!lat) { float* SR = a.out() + OUT_SR;
#pragma unroll
        for (int i = 0; i < 8; ++i) SR[((((size_t)(b * 2 + e) * 2 + dir) * 8 + h) * 64 + dg * 8 + i) * 64 + v] = S[i]; }
}

__device__ __forceinline__ void hgrn_chain(const Ctx& a, LAS unsigned char* lds, int tid, int oi, bool lat, int b, int h, int dir) {
    const bf16* Z = (const bf16*)(a.ws() + WS_Z); bf16* OFB = (bf16*)(a.ws() + WS_M + (dir ? 32 * MiB : 0));
    const int T = lat ? 1024 : 256; const size_t rowbase = lat ? (size_t)MP + (size_t)b * 1024 : (size_t)b * 256;
    const float* lower = (const float*)(a.ws() + WS_LOWER) + (size_t)(oi * 2 + dir) * 1024 + h * 128;
    const int v = tid & 127, dg = tid >> 7;
    float S[32]; const float* s0p = a.in(4);
#pragma unroll
    for (int i = 0; i < 32; ++i) S[i] = lat ? s0p[((((size_t)(b * 2 + oi) * 2 + dir) * 8 + h) * 128 + dg * 32 + i) * 128 + v] : 0.f;
    LAS float* sq = (LAS float*)lds; LAS float* sf = sq + 16 * 128; LAS float* sk = sf + 16 * 128; LAS float* sv = sk + 16 * 128; LAS float* part = sv + 16 * 128;
    for (int c0 = 0; c0 < T; c0 += 16) {
#pragma unroll
        for (int t = 0; t < 4; ++t) { const int idx = tid + NTHREADS * t, tok = idx >> 7, d = idx & 127; const int st = c0 + tok, n = dir ? T - 1 - st : st;
            const bf16* zr = Z + (rowbase + n) * NO_IN + h * 128 + d;
            const float qr = bf2f(zr[0]), fr = bf2f(zr[1024 + dir * 1024]), vi = bf2f(zr[3072]), lbv = lower[d];
            const float sg = sigmoid_f(fr), sgn = sigmoid_f(-fr);
            sq[idx] = qr * sigmoid_f(qr) * 0.08838834764831845f; sf[idx] = fmaxf(lbv + (1.f - lbv) * sg, 1e-30f); sk[idx] = (1.f - lbv) * sgn; sv[idx] = vi; }
        __syncthreads();
        for (int j = 0; j < 16; ++j) {
            const float vv = sv[j * 128 + v]; float acc = 0.f;
#pragma unroll
            for (int c = 0; c < 8; ++c) { const f32x4 f4 = *(const LAS f32x4*)(sf + j * 128 + dg * 32 + 4 * c), k4 = *(const LAS f32x4*)(sk + j * 128 + dg * 32 + 4 * c), q4 = *(const LAS f32x4*)(sq + j * 128 + dg * 32 + 4 * c);
                S[4 * c] = f4.x * S[4 * c] + k4.x * vv; acc += q4.x * S[4 * c];
                S[4 * c + 1] = f4.y * S[4 * c + 1] + k4.y * vv; acc += q4.y * S[4 * c + 1];
                S[4 * c + 2] = f4.z * S[4 * c + 2] + k4.z * vv; acc += q4.z * S[4 * c + 2];
                S[4 * c + 3] = f4.w * S[4 * c + 3] + k4.w * vv; acc += q4.w * S[4 * c + 3]; }
            part[(j * 4 + dg) * 128 + v] = acc; }
        __syncthreads();
#pragma unroll
        for (int t = 0; t < 4; ++t) { const int idx = tid + NTHREADS * t, tok = idx >> 7, vv = idx & 127;
            const float sum = (part[(tok * 4 + 0) * 128 + vv] + part[(tok * 4 + 1) * 128 + vv]) + (part[(tok * 4 + 2) * 128 + vv] + part[(tok * 4 + 3) * 128 + vv]);
            const int st = c0 + tok, n = dir ? T - 1 - st : st;
            OFB[(rowbase + n) * 1024 + h * 128 + vv] = f2bf16(sum); }
        __syncthreads();
    }
    if (!lat) { float* SH = a.out() + OUT_SH;
#pragma unroll
        for (int i = 0; i < 32; ++i) SH[((((size_t)(b * 2 + oi) * 2 + dir) * 8 + h) * 128 + dg * 32 + i) * 128 + v] = S[i]; }
}

__device__ __forceinline__ void phase_mix_even(const Ctx& a, LAS unsigned char* lds, int tid, int bid, int G, int e) {
    for (int s = bid; s < 256; s += G) {
        if (s < 128) ret_chain(a, lds, tid, e, true, s >> 4, (s >> 1) & 7, s & 1);
        else for (int j = 0; j < 4; ++j) { const int pc = (s - 128) * 4 + j; ret_chain(a, lds, tid, e, false, pc >> 4, (pc >> 1) & 7, pc & 1); } }
    for (int u = bid; u < 256; u += G) ctx_attn_unit(a, lds, tid, u >> 3, u & 7);
    for (int u = bid; u < 1024; u += G) na_unit(a, lds, tid, e, u >> 7, (u >> 4) & 7, u & 15);
}
__device__ __forceinline__ void phase_mix_odd(const Ctx& a, LAS unsigned char* lds, int tid, int bid, int G, int oi) {
    for (int s = bid; s < 256; s += G) {
        if (s < 128) hgrn_chain(a, lds, tid, oi, true, s >> 4, (s >> 1) & 7, s & 1);
        else for (int j = 0; j < 4; ++j) { const int pc = (s - 128) * 4 + j; hgrn_chain(a, lds, tid, oi, false, pc >> 4, (pc >> 1) & 7, pc & 1); } }
}
__device__ __forceinline__ void phase_fin(const Ctx& a, int l, int lane, int gw, int NGW) {
    const bf16* Z = (const bf16*)(a.ws() + WS_Z); const bf16* OF = (const bf16*)(a.ws() + WS_M); const bf16* OB = (const bf16*)(a.ws() + WS_M + 32 * MiB); bf16* O = (bf16*)(a.ws() + WS_H);
    const int head = lane >> 3, sub = lane & 7;
    if ((l & 1) == 0) {
        for (int row = gw; row < MROWS; row += NGW) { const int c0 = head * 64 + sub * 8;
            float f1[8], f2[8], gg[8]; unpack8(*(const GAS v4u*)(OF + (size_t)row * 1024 + c0), f1); unpack8(*(const GAS v4u*)(OB + (size_t)row * 1024 + c0), f2); unpack8(*(const GAS v4u*)(Z + (size_t)row * NE_IN + 3072 + c0), gg);
            float ss = 0.f;
#pragma unroll
            for (int i = 0; i < 8; ++i) { f1[i] += f2[i]; ss += f1[i] * f1[i]; }
            ss += __shfl_xor(ss, 1); ss += __shfl_xor(ss, 2); ss += __shfl_xor(ss, 4);
            const float rstd = rsqrtf(ss * (1.f / 64.f) + EPS_N);
#pragma unroll
            for (int i = 0; i < 8; ++i) f1[i] = f1[i] * rstd * (gg[i] * sigmoid_f(gg[i]));
            v4u w; w.x = pk2(f1[0], f1[1]); w.y = pk2(f1[2], f1[3]); w.z = pk2(f1[4], f1[5]); w.w = pk2(f1[6], f1[7]);
            *(GAS v4u*)(O + (size_t)row * 1024 + 512 + c0) = w; }
    } else {
        const int oi = l >> 1; const float* gn = a.in(17) + oi * 128 + sub * 16;
        for (int row = gw; row < MROWS; row += NGW) { const int c0 = head * 128 + sub * 16;
            float f[16]; float ss = 0.f;
#pragma unroll
            for (int hh = 0; hh < 2; ++hh) { float f1[8], f2[8]; unpack8(*(const GAS v4u*)(OF + (size_t)row * 1024 + c0 + 8 * hh), f1); unpack8(*(const GAS v4u*)(OB + (size_t)row * 1024 + c0 + 8 * hh), f2);
#pragma unroll
                for (int i = 0; i < 8; ++i) { f[8 * hh + i] = f1[i] + f2[i]; ss += f[8 * hh + i] * f[8 * hh + i]; } }
            ss += __shfl_xor(ss, 1); ss += __shfl_xor(ss, 2); ss += __shfl_xor(ss, 4);
            const float rstd = rsqrtf(ss * (1.f / 128.f) + EPS_N);
#pragma unroll
            for (int hh = 0; hh < 2; ++hh) { float gg[8]; unpack8(*(const GAS v4u*)(Z + (size_t)row * NO_IN + 4096 + c0 + 8 * hh), gg); float o8[8];
#pragma unroll
                for (int i = 0; i < 8; ++i) o8[i] = f[8 * hh + i] * rstd * gn[8 * hh + i] * (gg[i] * sigmoid_f(gg[i]));
                v4u w; w.x = pk2(o8[0], o8[1]); w.y = pk2(o8[2], o8[3]); w.z = pk2(o8[4], o8[5]); w.w = pk2(o8[6], o8[7]);
                *(GAS v4u*)(O + (size_t)row * 1024 + c0 + 8 * hh) = w; } }
    }
}

constexpr int NPHASES = 34;
__global__ void __launch_bounds__(NTHREADS, 2) mk_fwd(Args args) {
    extern __shared__ __attribute__((aligned(16))) unsigned char lds_raw[];
    LAS unsigned char* lds = (LAS unsigned char*)lds_raw;
    const int tid = threadIdx.x, bid = blockIdx.x, G = gridDim.x, NGW = G * NWAVES;
    volatile LAS unsigned* MISC = (volatile LAS unsigned*)(lds + MISC_OFF);
    for (int u = tid; u < (LDS_BYTES - LDSCTL_OFF) / 4; u += NTHREADS) ((LAS unsigned*)(lds + LDSCTL_OFF))[u] = 0u;
    __syncthreads();
    if (tid == 0) { LAS unsigned long long* t = (LAS unsigned long long*)(lds + LDSCTL_OFF);
#pragma unroll
        for (int i = 0; i < 20; ++i) t[i] = (unsigned long long)args.in[i];
        t[20] = (unsigned long long)args.out; t[21] = (unsigned long long)args.ws; }
    __syncthreads();
    const Ctx ctx{lds};
    const int ph_lo = args.ph_lo, ph_hi = args.ph_hi;
    XcdBarrier bar = xcd_barrier_post((unsigned*)((gu32*)(ctx.ws() + WS_CTL) + CW_BAR), MISC + 8);
    const int tid0 = tid, bid0 = bid;
    for (int ph = ph_lo; ph < ph_hi; ++ph) {
        const Ctx& args = ctx;
        int tid = tid0, bid = bid0; asm volatile("" : "+v"(tid)); asm volatile("" : "+s"(bid));
        const int lane = tid & 63, wave = __builtin_amdgcn_readfirstlane(tid >> 6), gw = bid * NWAVES + wave;
        if (ph == 0) phase_p0(args, lds, tid, lane, wave, bid, G);
        else if (ph == 1) phase_rowpass(args, 0, 0, lane, gw, NGW);
        else {
            const int l = (ph - 2) >> 3, sub = (ph - 2) & 7, e = l >> 1;
            const bf16* Hb = (const bf16*)(args.ws() + WS_H); bf16* Zb = (bf16*)(args.ws() + WS_Z); float* Mb = (float*)(args.ws() + WS_M);
            if (sub == 0) {
                if ((l & 1) == 0) { pg8::Gemm g{Hb, (const bf16*)(args.ws() + WS_WTE_IN) + (size_t)e * NE_IN * 1024, MROWS, NE_IN, 1024}; pg8::StaticOrder S; S.init(MROWS, NE_IN, G, bid);
                    pg8::EpiZ E{Zb, NE_IN, args.out() + OUT_KV, e}; pg8::gemm_phase<pg8::EpiZ, pg8::StaticOrder, true, true>(lds, g, S, E); }
                else { pg8::Gemm g{Hb, (const bf16*)(args.ws() + WS_WTO_IN) + (size_t)e * NO_IN * 1024, MROWS, NO_IN, 1024}; pg8::StaticOrder S; S.init(MROWS, NO_IN, G, bid);
                    pg8::EpiZ E{Zb, NO_IN, nullptr, 0}; pg8::gemm_phase<pg8::EpiZ, pg8::StaticOrder, true, true>(lds, g, S, E); }
            } else if (sub == 1) {
                if ((l & 1) == 0) phase_mix_even(args, lds, tid, bid, G, e); else phase_mix_odd(args, lds, tid, bid, G, e);
            } else if (sub == 2) phase_fin(args, l, lane, gw, NGW);
            else if (sub == 3) {
                const bf16* Wt = ((l & 1) == 0) ? (const bf16*)(args.ws() + WS_WTE_OUT) + (size_t)e * 1048576 : (const bf16*)(args.ws() + WS_WTO_OUT) + (size_t)e * 1048576;
                pg8::Gemm g{Hb, Wt, MROWS, 1024, 1024}; pg8::StaticOrder S; S.init(MROWS, 1024, G, bid);
                pg8::EpiF32 E{Mb, 1024}; pg8::gemm_phase<pg8::EpiF32, pg8::StaticOrder, true, true>(lds, g, S, E);
            } else if (sub == 4) phase_rowpass(args, l, 1, lane, gw, NGW);
            else if (sub == 5) {
                pg8::Gemm g{Hb, (const bf16*)(args.ws() + WS_WTF_IN) + (size_t)l * NFF_IN * 1024, MROWS, NFF_IN, 1024}; pg8::StaticOrder S; S.init(MROWS, NFF_IN, G, bid);
                pg8::EpiSwiglu E{Zb, DFF}; pg8::gemm_phase<pg8::EpiSwiglu, pg8::StaticOrder, true, true>(lds, g, S, E);
            } else if (sub == 6) {
                pg8::Gemm g{Zb, (const bf16*)(args.ws() + WS_WTF_OUT) + (size_t)l * 1024 * DFF, MROWS, 1024, DFF}; pg8::StaticOrder S; S.init(MROWS, 1024, G, bid);
                pg8::EpiF32 E{Mb, 1024}; pg8::gemm_phase<pg8::EpiF32, pg8::StaticOrder, true, true>(lds, g, S, E);
            } else phase_rowpass(args, l, 2, lane, gw, NGW);
        }
        if (ph + 1 < ph_hi) { xcd_barrier(bar); }
    }
}

extern "C" void kernel_launch(void* const* d_in, const int* in_sizes, int n_in, void* d_out, int out_size, void* d_ws, size_t ws_size, hipStream_t stream) {
    static int grid = 0;
    if (grid == 0) {
        if (n_in != 20 || ws_size < WS_END) { fprintf(stderr, "kernel_launch: need 20 inputs and >= %zu bytes of workspace; got n_in %d, ws %zu\n", (size_t)WS_END, n_in, ws_size); grid = -1; return; }
        int dev = 0, cus = 0, per_cu = 0;
        if (hipGetDevice(&dev) != hipSuccess || hipDeviceGetAttribute(&cus, hipDeviceAttributeMultiprocessorCount, dev) != hipSuccess) { fprintf(stderr, "kernel_launch: device query failed\n"); grid = -1; return; }
        if (hipFuncSetAttribute((const void*)mk_fwd, hipFuncAttributeMaxDynamicSharedMemorySize, LDS_BYTES) != hipSuccess) { fprintf(stderr, "kernel_launch: hipFuncSetAttribute failed\n"); grid = -1; return; }
        if (hipOccupancyMaxActiveBlocksPerMultiprocessor(&per_cu, (const void*)mk_fwd, NTHREADS, LDS_BYTES) != hipSuccess || per_cu < 1) { fprintf(stderr, "kernel_launch: occupancy query reports %d blocks per CU\n", per_cu); per_cu = 1; }
        (void)hipGetLastError();
        grid = cus;
    }
    if (grid < 0) return;
    (void)hipMemsetAsync((char*)d_ws + WS_CTL, 0, CTL_ZERO_BYTES, stream);
    Args a{};
    for (int i = 0; i < 20; ++i) a.in[i] = (const float*)d_in[i];
    a.out = (float*)d_out; a.ws = (unsigned char*)d_ws;
#if MK_PER_PHASE
    for (int ph = 0; ph < NPHASES; ++ph) { a.ph_lo = ph; a.ph_hi = ph + 1; hipLaunchKernelGGL(mk_fwd, dim3(grid), dim3(NTHREADS), LDS_BYTES, stream, a); }
#else
    a.ph_lo = 0; a.ph_hi = NPHASES;
    void* params[] = {&a};
    hipError_t e = hipLaunchCooperativeKernel((const void*)mk_fwd, dim3(grid), dim3(NTHREADS), params, LDS_BYTES, stream);
    if (e != hipSuccess) fprintf(stderr, "kernel_launch: cooperative launch failed: %s (grid %d)\n", hipGetErrorString(e), grid);
#endif
}
```

```cpp
#include <hip/hip_runtime.h>
#include <cstdio>
#include <cstdint>
#include <cmath>
#ifndef MK_PER_PHASE
#define MK_PER_PHASE 0
#endif
namespace pg8 {
#define PG8_LAS __attribute__((address_space(3)))
#define PG8_GAS __attribute__((address_space(1)))
typedef unsigned short bf16_t;
typedef short bf16x8 __attribute__((ext_vector_type(8)));
typedef float f32x4 __attribute__((ext_vector_type(4)));
typedef unsigned u32x4 __attribute__((ext_vector_type(4)));
constexpr int BM = 256, BK = 64, HALF = 128, HTB = HALF * BK * 2  , STAGE_BYTES = 8 * HTB, NXCD = 8, WGM = 8;

__host__ __device__ __forceinline__ int lds_byte(int r, int c) { const int st = (r >> 4) * 2 + (c >> 5), rr = r & 15, cc = c & 31, ob = rr * 64 + cc * 2; return st * 1024 + (ob ^ (((ob >> 9) & 1) << 5)); }
__host__ __device__ __forceinline__ void stage_rc(int b, int& R, int& C) { const int st = b / 1024, sb = b % 1024, swz = sb ^ (((sb >> 9) & 1) << 5); R = (st >> 1) * 16 + swz / 64; C = (st & 1) * 32 + (swz % 64) / 2; }
__host__ __device__ __forceinline__ int perm32(int rho) { const int n = rho >> 4, i = rho & 15; return 8 * (i >> 2) + 4 * n + (i & 3); }

struct Unit { int pm, pn; };
struct Gemm { const PG8_GAS bf16_t* A; const PG8_GAS bf16_t* Bt; int M, N, K; };

struct StaticOrder {
    int nM, nN, nwg, G, c;
    __host__ __device__ void init(int M, int N, int G_, int c_) { nM = M / BM; nN = N / BM; nwg = nM * nN; G = G_; c = c_; }
    __host__ __device__ bool next(int i, Unit& u) const {
        const long L = (long)i * G + c; if (L >= nwg) return false;
        int wgid = (int)L; { const int q = nwg / NXCD, r = nwg % NXCD, xcd = wgid % NXCD, off = wgid / NXCD; wgid = (xcd < r ? xcd * (q + 1) : r * (q + 1) + (xcd - r) * q) + off; }
        const int nig = WGM * nN, gid = wgid / nig, fm = gid * WGM, gsz = (nM - fm) < WGM ? (nM - fm) : WGM;
        u.pm = fm + ((wgid % nig) % gsz); u.pn = (wgid % nig) / gsz; return true;
    }
    __device__ __forceinline__ void a_ready(const Unit&) const {}
    __device__ __forceinline__ void done(const Unit&) const {}
};

__device__ __forceinline__ unsigned cvt_pk_bf16(float lo, float hi) { unsigned r; asm volatile("v_cvt_pk_bf16_f32 %0, %1, %2" : "=v"(r) : "v"(lo), "v"(hi)); return r; }
typedef unsigned u32x2e __attribute__((ext_vector_type(2)));
__device__ __forceinline__ float silu_f(float a) { return a * __builtin_amdgcn_rcpf(1.0f + __expf(-a)); }
struct EpiZ {
    static constexpr bool PERM = true, AFTER_DRAIN = false;
    PG8_GAS bf16_t* O; int ldc; PG8_GAS float* kv; int e;
    __device__ __forceinline__ void operator()(const f32x4 (&acc)[2][2][4][2], const Unit& u, int wr, int wc, int fr, int fq) const {
        const int row0 = u.pm * BM + wr * 64 + fr, col0 = u.pn * BM + wc * 32 + 8 * fq;
        const bool do_kv = (kv != nullptr) && (u.pm < 32) && (u.pn >= 2) && (u.pn < 6);
#pragma unroll
        for (int ai = 0; ai < 2; ++ai)
#pragma unroll
            for (int m = 0; m < 4; ++m) { const int row = row0 + ai * HALF + m * 16; PG8_GAS bf16_t* rowp = O + (size_t)row * ldc + col0;
#pragma unroll
                for (int bj = 0; bj < 2; ++bj) { const f32x4 v0 = acc[ai][bj][m][0], v1 = acc[ai][bj][m][1];
                    u32x4 w; w.x = cvt_pk_bf16(v0[0], v0[1]); w.y = cvt_pk_bf16(v0[2], v0[3]); w.z = cvt_pk_bf16(v1[0], v1[1]); w.w = cvt_pk_bf16(v1[2], v1[3]);
                    *(PG8_GAS u32x4*)(rowp + bj * HALF) = w;
                    if (do_kv) { const int c = col0 + bj * HALF - 512, kvi = c >> 9, hh = (c & 511) >> 6, d = c & 63, b = row >> 8, t = row & 255;
                        PG8_GAS float* p = kv + ((((size_t)(b * 2 + e) * 2 + kvi) * 8 + hh) * 256 + t) * 64 + d;
                        *(PG8_GAS f32x4*)p = v0; *(PG8_GAS f32x4*)(p + 4) = v1; } } }
    }
};
struct EpiF32 {
    static constexpr bool PERM = false, AFTER_DRAIN = false;
    PG8_GAS float* O; int ldc;
    __device__ __forceinline__ void operator()(const f32x4 (&acc)[2][2][4][2], const Unit& u, int wr, int wc, int fr, int fq) const {
        const int row0 = u.pm * BM + wr * 64 + fr, col0 = u.pn * BM + wc * 32 + 4 * fq;
#pragma unroll
        for (int ai = 0; ai < 2; ++ai)
#pragma unroll
            for (int m = 0; m < 4; ++m) { PG8_GAS float* rowp = O + (size_t)(row0 + ai * HALF + m * 16) * ldc + col0;
#pragma unroll
                for (int bj = 0; bj < 2; ++bj)
#pragma unroll
                    for (int n = 0; n < 2; ++n) *(PG8_GAS f32x4*)(rowp + bj * HALF + n * 16) = acc[ai][bj][m][n]; }
    }
};
struct EpiSwiglu {
    static constexpr bool PERM = true, AFTER_DRAIN = false;
    PG8_GAS bf16_t* O; int ldc;
    __device__ __forceinline__ void operator()(const f32x4 (&acc)[2][2][4][2], const Unit& u, int wr, int wc, int fr, int fq) const {
        const int row0 = u.pm * BM + wr * 64 + fr, col0 = u.pn * HALF + wc * 32 + 8 * fq;
#pragma unroll
        for (int ai = 0; ai < 2; ++ai)
#pragma unroll
            for (int m = 0; m < 4; ++m) { PG8_GAS bf16_t* rowp = O + (size_t)(row0 + ai * HALF + m * 16) * ldc + col0;
                const f32x4 a0 = acc[ai][0][m][0], a1 = acc[ai][0][m][1], u0 = acc[ai][1][m][0], u1 = acc[ai][1][m][1];
                u32x4 w;
                w.x = cvt_pk_bf16(silu_f(a0[0]) * u0[0], silu_f(a0[1]) * u0[1]); w.y = cvt_pk_bf16(silu_f(a0[2]) * u0[2], silu_f(a0[3]) * u0[3]);
                w.z = cvt_pk_bf16(silu_f(a1[0]) * u1[0], silu_f(a1[1]) * u1[1]); w.w = cvt_pk_bf16(silu_f(a1[2]) * u1[2], silu_f(a1[3]) * u1[3]);
                *(PG8_GAS u32x4*)rowp = w; }
    }
};
template <class Epi, class Sched, bool ALIGN_EPI = false, bool SP2 = false>
__device__ __forceinline__ void gemm_phase(PG8_LAS unsigned char* lds, const Gemm g, const Sched& S, const Epi& E) {
    int tid_ = threadIdx.x; asm volatile("" : "+v"(tid_)); const int tid = tid_, wid = __builtin_amdgcn_readfirstlane(tid >> 6), lane = tid & 63, wr = wid >> 2, wc = wid & 3, fr = lane & 15, fq = lane >> 4;
    const int K = g.K, nt = K / BK;
    unsigned voffA[2], voffB[2];
#pragma unroll
    for (int i = 0; i < 2; ++i) { int R, C; stage_rc(tid * 16 + i * 8192, R, C); const int Rb = Epi::PERM ? ((R & ~31) + perm32(R & 31)) : R;
        voffA[i] = (unsigned)(R * K + C) * 2u; voffB[i] = (unsigned)(Rb * K + C) * 2u; }
    const size_t kstep = (size_t)(BK * 2);
    const size_t hstep = (size_t)HALF * K * 2;
    const size_t tstep = 2 * hstep;
    const unsigned ldsw = (unsigned)wid * 1024u;
    const int aoff = lds_byte(wr * 64 + fr, fq * 8), boff = lds_byte(wc * 32 + fr, fq * 8);
#define PG8_SA(b, h) (((b) * 2 + (h)) * HTB)
#define PG8_SB(b, h) ((4 + (b) * 2 + (h)) * HTB)
#define PG8_STAGE(bufoff, gbase, voff) do { _Pragma("unroll") for (int _i = 0; _i < 2; ++_i) \
        __builtin_amdgcn_global_load_lds((const PG8_GAS unsigned*)((const PG8_GAS char*)(gbase) + (voff)[_i]), (PG8_LAS unsigned*)(lds + (bufoff) + ldsw + _i * 8192), 16, 0, 0); } while (0)
#define PG8_LDA(dst, b, h) do { _Pragma("unroll") for (int m = 0; m < 4; ++m) _Pragma("unroll") for (int k = 0; k < 2; ++k) dst[m][k] = *(const PG8_LAS bf16x8*)(lds + PG8_SA(b, h) + aoff + m * 2048 + k * 1024); } while (0)
#define PG8_LDB(dst, b, h) do { _Pragma("unroll") for (int n = 0; n < 2; ++n) _Pragma("unroll") for (int k = 0; k < 2; ++k) dst[n][k] = *(const PG8_LAS bf16x8*)(lds + PG8_SB(b, h) + boff + n * 2048 + k * 1024); } while (0)
#define PG8_MMA(ai, bj, At, Bt) do { __builtin_amdgcn_s_setprio(1); _Pragma("unroll") for (int m = 0; m < 4; ++m) _Pragma("unroll") for (int n = 0; n < 2; ++n) _Pragma("unroll") for (int k = 0; k < 2; ++k) \
        acc[ai][bj][m][n] = __builtin_amdgcn_mfma_f32_16x16x32_bf16(Bt[n][k], At[m][k], acc[ai][bj][m][n], 0, 0, 0); __builtin_amdgcn_s_setprio(0); } while (0)
#define PG8_WAIT_V(n) asm volatile("s_waitcnt vmcnt(" #n ")" ::: "memory")
#define PG8_WAIT_L(n) asm volatile("s_waitcnt lgkmcnt(" #n ")" ::: "memory")
#define PG8_BAR __builtin_amdgcn_s_barrier()
#define PG8_SCHED __builtin_amdgcn_sched_barrier(0)
    Unit cur, nxt; int ui = 0;
    if (!S.next(0, cur)) return;
    f32x4 acc[2][2][4][2];
#pragma unroll
    for (int a = 0; a < 2; ++a)
#pragma unroll
        for (int b = 0; b < 2; ++b)
#pragma unroll
            for (int m = 0; m < 4; ++m)
#pragma unroll
                for (int n = 0; n < 2; ++n) acc[a][b][m][n] = (f32x4){0.f, 0.f, 0.f, 0.f};
    bf16x8 At[4][2], B0[2][2], B1[2][2];
    const PG8_GAS char* cA = (const PG8_GAS char*)g.A + (size_t)cur.pm * tstep; const PG8_GAS char* cB = (const PG8_GAS char*)g.Bt + (size_t)cur.pn * tstep;
    S.a_ready(cur);
    if constexpr (SP2) {
        PG8_STAGE(PG8_SB(0, 0), cB, voffB); PG8_STAGE(PG8_SB(0, 1), cB + hstep, voffB); PG8_STAGE(PG8_SA(0, 0), cA, voffA); PG8_STAGE(PG8_SA(0, 1), cA + hstep, voffA);
        if (wr == 1) PG8_BAR;
        PG8_WAIT_V(2); PG8_BAR;
        PG8_STAGE(PG8_SB(1, 0), cB + kstep, voffB); PG8_STAGE(PG8_SA(1, 0), cA + kstep, voffA); PG8_STAGE(PG8_SB(1, 1), cB + hstep + kstep, voffB);
        PG8_WAIT_V(6); PG8_BAR;
    } else {
        PG8_STAGE(PG8_SB(0, 0), cB, voffB); PG8_STAGE(PG8_SA(0, 0), cA, voffA); PG8_STAGE(PG8_SB(0, 1), cB + hstep, voffB); PG8_STAGE(PG8_SA(0, 1), cA + hstep, voffA);
        if (wr == 1) PG8_BAR;
        PG8_WAIT_V(4); PG8_BAR;
        PG8_STAGE(PG8_SB(1, 0), cB + kstep, voffB); PG8_STAGE(PG8_SA(1, 0), cA + kstep, voffA); PG8_STAGE(PG8_SB(1, 1), cB + hstep + kstep, voffB);
        PG8_WAIT_V(6); PG8_BAR;
    }
    for (;;) {
        const bool has_next = S.next(ui + 1, nxt);
        const PG8_GAS char* nA = has_next ? (const PG8_GAS char*)g.A + (size_t)nxt.pm * tstep : cA; const PG8_GAS char* nB = has_next ? (const PG8_GAS char*)g.Bt + (size_t)nxt.pn * tstep : cB;
        for (int t = 0; t < nt; t += 2) {
            const bool last = (t == nt - 2);
            const PG8_GAS char* a1 = cA + (size_t)(t + 1) * kstep;
            const PG8_GAS char* a2 = last ? nA : cA + (size_t)(t + 2) * kstep; const PG8_GAS char* b2 = last ? nB : cB + (size_t)(t + 2) * kstep;
            const PG8_GAS char* a3 = a2 + kstep; const PG8_GAS char* b3 = b2 + kstep;
            if (last && has_next) S.a_ready(nxt);
            if constexpr (SP2) {
            PG8_LDB(B0, 0, 0); PG8_LDB(B1, 0, 1); PG8_SCHED; PG8_LDA(At, 0, 0); PG8_STAGE(PG8_SA(1, 1), a1 + hstep, voffA);
            PG8_WAIT_V(8); PG8_WAIT_L(0); PG8_BAR; PG8_MMA(0, 0, At, B0); PG8_MMA(0, 1, At, B1); PG8_BAR; PG8_SCHED;
            PG8_LDA(At, 0, 1); PG8_STAGE(PG8_SB(0, 0), b2, voffB); PG8_STAGE(PG8_SB(0, 1), b2 + hstep, voffB); PG8_STAGE(PG8_SA(0, 0), a2, voffA);
            PG8_WAIT_V(8); PG8_WAIT_L(0); PG8_BAR; PG8_MMA(1, 0, At, B0); PG8_MMA(1, 1, At, B1); PG8_BAR; PG8_SCHED;
            PG8_LDB(B0, 1, 0); PG8_LDB(B1, 1, 1); PG8_SCHED; PG8_LDA(At, 1, 0); PG8_STAGE(PG8_SA(0, 1), a2 + hstep, voffA);
            PG8_WAIT_V(8); PG8_WAIT_L(0); PG8_BAR; PG8_MMA(0, 0, At, B0); PG8_MMA(0, 1, At, B1); PG8_BAR; PG8_SCHED;
            PG8_LDA(At, 1, 1); PG8_STAGE(PG8_SB(1, 0), b3, voffB); PG8_STAGE(PG8_SB(1, 1), b3 + hstep, voffB); PG8_STAGE(PG8_SA(1, 0), a3, voffA);
            PG8_WAIT_V(8); PG8_WAIT_L(0); PG8_BAR; PG8_MMA(1, 0, At, B0); PG8_MMA(1, 1, At, B1); PG8_BAR; PG8_SCHED;
            } else {
            PG8_LDB(B0, 0, 0); PG8_SCHED; PG8_LDA(At, 0, 0); PG8_STAGE(PG8_SA(1, 1), a1 + hstep, voffA);
            PG8_WAIT_L(8); PG8_BAR; PG8_WAIT_L(0); PG8_MMA(0, 0, At, B0); PG8_BAR; PG8_SCHED;
            PG8_LDB(B1, 0, 1); PG8_STAGE(PG8_SB(0, 0), b2, voffB);
            PG8_BAR; PG8_WAIT_L(0); PG8_MMA(0, 1, At, B1); PG8_BAR;
            PG8_LDA(At, 0, 1); PG8_STAGE(PG8_SA(0, 0), a2, voffA);
            PG8_BAR; PG8_WAIT_L(0); PG8_MMA(1, 0, At, B0); PG8_BAR; PG8_SCHED;
            PG8_STAGE(PG8_SB(0, 1), b2 + hstep, voffB);
            PG8_WAIT_V(6); PG8_BAR; PG8_MMA(1, 1, At, B1); PG8_BAR;
            PG8_LDB(B0, 1, 0); PG8_SCHED; PG8_LDA(At, 1, 0); PG8_STAGE(PG8_SA(0, 1), a2 + hstep, voffA);
            PG8_WAIT_L(8); PG8_BAR; PG8_WAIT_L(0); PG8_MMA(0, 0, At, B0); PG8_BAR; PG8_SCHED;
            PG8_LDB(B1, 1, 1); PG8_STAGE(PG8_SB(1, 0), b3, voffB);
            PG8_BAR; PG8_WAIT_L(0); PG8_MMA(0, 1, At, B1); PG8_BAR;
            PG8_LDA(At, 1, 1); PG8_STAGE(PG8_SA(1, 0), a3, voffA);
            PG8_BAR; PG8_WAIT_L(0); PG8_MMA(1, 0, At, B0); PG8_BAR; PG8_SCHED;
            PG8_STAGE(PG8_SB(1, 1), b3 + hstep, voffB);
            PG8_WAIT_V(6); PG8_BAR; PG8_MMA(1, 1, At, B1); PG8_BAR;
            }
        }
        if constexpr (ALIGN_EPI) { if (wr == 0) PG8_BAR; }
        if constexpr (!Epi::AFTER_DRAIN) { E(acc, cur, wr, wc, fr, fq); S.done(cur); }
        if (!has_next) break;
#pragma unroll
        for (int a = 0; a < 2; ++a)
#pragma unroll
            for (int b = 0; b < 2; ++b)
#pragma unroll
                for (int m = 0; m < 4; ++m)
#pragma unroll
                    for (int n = 0; n < 2; ++n) acc[a][b][m][n] = (f32x4){0.f, 0.f, 0.f, 0.f};
        cur = nxt; cA = nA; cB = nB; ++ui;
        if constexpr (ALIGN_EPI) { if (wr == 1) PG8_BAR; }
    }
    PG8_WAIT_V(0);
    if constexpr (!ALIGN_EPI) { if (wr == 0) PG8_BAR; }
    PG8_BAR;
    if constexpr (Epi::AFTER_DRAIN) { E.fused(acc, cur, wr, wc, fr, fq, lds, wid, lane); S.done(cur); }
#undef PG8_SA
#undef PG8_SB
#undef PG8_STAGE
#undef PG8_LDA
#undef PG8_LDB
#undef PG8_MMA
#undef PG8_WAIT_V
#undef PG8_WAIT_L
#undef PG8_BAR
#undef PG8_SCHED
}
}
#define GAS __attribute__((address_space(1)))
#define LAS __attribute__((address_space(3)))
typedef unsigned short bf16;
typedef unsigned v4u __attribute__((ext_vector_type(4)));
typedef float f32x4 __attribute__((ext_vector_type(4)));
typedef short bf16x8 __attribute__((ext_vector_type(8)));
typedef GAS unsigned gu32;
typedef GAS unsigned long long gu64;
#define RLX_AGENT __ATOMIC_RELAXED, __HIP_MEMORY_SCOPE_AGENT
#define LDS_WAIT() asm volatile("s_waitcnt lgkmcnt(0)" ::: "memory")
#define VM_WAIT() asm volatile("s_waitcnt vmcnt(0)" ::: "memory")
__device__ __forceinline__ unsigned long long rt() { return __builtin_amdgcn_s_memrealtime(); }
__device__ __forceinline__ unsigned f2bf(float f) { unsigned u = __builtin_bit_cast(unsigned, f); return (u + 0x7fffu + ((u >> 16) & 1u)) >> 16; }
__device__ __forceinline__ unsigned pk2(float lo, float hi) { return f2bf(lo) | (f2bf(hi) << 16); }
#define XB_TMO      128
#define XB_XCNT(j)  (256  + 64 * (j))
#define XB_XSUB(j)  (1280 + 64 * (j))
#define XB_XGEN(j)  (2304 + 64 * (j))
#define XB_TOP      3328
#define XB_TOPGEN   3392
#define XCD_BAR_WORDS 3456
#define XB_SPIN_CAP (1u << 18)

__device__ __forceinline__ unsigned xb_ld(unsigned* p)              { return __hip_atomic_load(p, __ATOMIC_RELAXED, __HIP_MEMORY_SCOPE_AGENT); }
__device__ __forceinline__ unsigned xb_add(unsigned* p, unsigned v) { return __hip_atomic_fetch_add(p, v, __ATOMIC_RELAXED, __HIP_MEMORY_SCOPE_AGENT); }
__device__ __forceinline__ unsigned xb_xcc_id() { return (unsigned)__builtin_amdgcn_s_getreg((3 << 11) | 20) & 0xFu; }
#define XB_SPIN(cond, bar) do { unsigned _sp = 0; while (cond) { __builtin_amdgcn_s_sleep(1); \
    if ((++_sp & 255u) == 0u) { if (xb_ld(&(bar)[XB_TMO])) break; if (_sp > XB_SPIN_CAP) { atomicAdd(&(bar)[XB_TMO], 1u); break; } } } } while (0)

struct XcdBarrier {
    unsigned* bar; unsigned x;
    volatile LAS unsigned* st;
};

__device__ __forceinline__ XcdBarrier xcd_barrier_post(unsigned* bar, volatile LAS unsigned* st) {
    XcdBarrier b; b.bar = bar; b.x = xb_xcc_id(); b.st = st;
    if (threadIdx.x == 0) (void)xb_add(&bar[XB_XCNT(b.x)], 1u);
    return b;
}
__device__ __forceinline__ void xcd_barrier_complete(unsigned* bar, unsigned x, unsigned& nloc, unsigned& nx) {
    const unsigned G = gridDim.x * gridDim.y * gridDim.z;
    unsigned sum, cnt, mine, sp = 0u;
    for (;;) {
        sum = 0u; cnt = 0u; mine = 0u;
#pragma unroll
        for (unsigned j = 0; j < 16; ++j) { const unsigned c = xb_ld(&bar[XB_XCNT(j)]); sum += c; cnt += (c > 0u) ? 1u : 0u; mine = (j == x) ? c : mine; }
        if (sum == G) break;
        __builtin_amdgcn_s_sleep(1);
        if ((++sp & 255u) == 0u) { if (xb_ld(&bar[XB_TMO])) break; if (sp > XB_SPIN_CAP) { atomicAdd(&bar[XB_TMO], 1u); break; } }
    }
    nloc = mine > 0u ? mine : 1u; nx = cnt > 0u ? cnt : 1u;
}

__device__ __forceinline__ void xcd_barrier(const XcdBarrier& b) {
    asm volatile("s_waitcnt vmcnt(0)" ::: "memory");
    __syncthreads();
    if (threadIdx.x == 0) {
        unsigned* bar = b.bar;
        __builtin_amdgcn_s_waitcnt(0);
        unsigned nloc = b.st[0], nx = b.st[1];
        if (nloc == 0u) { xcd_barrier_complete(bar, b.x, nloc, nx); b.st[0] = nloc; b.st[1] = nx; }
        const unsigned old = xb_add(&bar[XB_XSUB(b.x)], 1u);
        const unsigned gen = old / nloc;
        if (old + 1u == (gen + 1u) * nloc) {
            __builtin_amdgcn_fence(__ATOMIC_RELEASE, "agent");
            asm volatile("s_waitcnt vmcnt(0)" ::: "memory");
            const unsigned og = xb_add(&bar[XB_TOP], 1u);
            const unsigned tg = og / nx;
            if (og + 1u == (tg + 1u) * nx) xb_add(&bar[XB_TOPGEN], 1u);
            else XB_SPIN(xb_ld(&bar[XB_TOPGEN]) == tg, bar);
            __builtin_amdgcn_fence(__ATOMIC_ACQUIRE, "agent");
            xb_add(&bar[XB_XGEN(b.x)], 1u);
            asm volatile("s_waitcnt vmcnt(0)" ::: "memory");
        } else {
            XB_SPIN(xb_ld(&bar[XB_XGEN(b.x)]) == gen, bar);
            __builtin_amdgcn_fence(__ATOMIC_ACQUIRE, "agent");
            asm volatile("s_waitcnt vmcnt(0)" ::: "memory");
        }
    }
    __syncthreads();
}
constexpr int NWAVES = 8, NTHREADS = 512;
constexpr int DM = 1024, MROWS = 16384, MP = 8192;
constexpr int NE_IN = 3584, NO_IN = 5120, DFF = 2816, NFF_IN = 5632;
constexpr float EPS_N = 1e-6f;
constexpr size_t OUT_KV = 16777216, OUT_SR = 33554432, OUT_SH = 37748736;
constexpr size_t MiB = 1u << 20;
constexpr size_t WS_CTL = 0, WS_MOD = 1 * MiB, CTL_ZERO_BYTES = 2 * MiB;
constexpr size_t WS_LOWER = 2 * MiB;
constexpr size_t WS_WTE_IN = 3 * MiB, WS_WTE_OUT = 17 * MiB, WS_WTO_IN = 21 * MiB, WS_WTO_OUT = 41 * MiB, WS_WTF_IN = 45 * MiB, WS_WTF_OUT = 89 * MiB;
constexpr size_t WS_H = 111 * MiB;
constexpr size_t WS_Z = 143 * MiB;
constexpr size_t WS_M = 303 * MiB;
constexpr size_t WS_END = 367 * MiB;
constexpr int CW_BAR = 4096;

constexpr int RING_BYTES = 131072, LDSCTL_OFF = RING_BYTES, MISC_OFF = LDSCTL_OFF + 320, LDS_BYTES = 147456;

__device__ __forceinline__ float bf2f(unsigned short b) { return __uint_as_float((unsigned)b << 16); }
__device__ __forceinline__ void unpack8(const v4u w, float (&f)[8]) {
    f[0] = __uint_as_float(w.x << 16); f[1] = __uint_as_float(w.x & 0xffff0000u); f[2] = __uint_as_float(w.y << 16); f[3] = __uint_as_float(w.y & 0xffff0000u);
    f[4] = __uint_as_float(w.z << 16); f[5] = __uint_as_float(w.z & 0xffff0000u); f[6] = __uint_as_float(w.w << 16); f[7] = __uint_as_float(w.w & 0xffff0000u);
}
__device__ __forceinline__ unsigned short f2bf16(float f) { return (unsigned short)f2bf(f); }
__device__ __forceinline__ float wave_sum(float v) {
#pragma unroll
    for (int o = 1; o < 64; o <<= 1) v += __shfl_xor(v, o);
    return v;
}
__device__ __forceinline__ float sigmoid_f(float x) { return 1.0f / (1.0f + __expf(-x)); }

struct Args { const float* in[20]; float* out; unsigned char* ws; int ph_lo, ph_hi; };
struct Ctx {
    LAS unsigned char* lds;
    __device__ __forceinline__ unsigned long long rd(int i) const { volatile LAS unsigned long long* t = (volatile LAS unsigned long long*)(lds + LDSCTL_OFF); const unsigned long long v = t[i];
        const unsigned lo = __builtin_amdgcn_readfirstlane((unsigned)v), hi = __builtin_amdgcn_readfirstlane((unsigned)(v >> 32)); return ((unsigned long long)hi << 32) | lo; }
    __device__ __forceinline__ const GAS float* in(int i) const { return (const GAS float*)rd(i); }
    __device__ __forceinline__ GAS float* out() const { return (GAS float*)rd(20); }
    __device__ __forceinline__ GAS unsigned char* ws() const { return (GAS unsigned char*)rd(21); }
};

template <bool FFN>
__device__ __forceinline__ void transpose_item(const GAS float* W, int K, int N, GAS bf16* WT, LAS float* scr, int item, int lane) {
    const int nblk = N / 32, kb = item / nblk, nb = item % nblk, k0 = 64 * kb, n0d = 32 * nb;
    int n0s = n0d;
    if (FFN) { const int tile = n0d >> 8, within = n0d & 255; n0s = (within < 128) ? tile * 128 + within : DFF + tile * 128 + (within - 128); }
#pragma unroll 8
    for (int i = 0; i < 32; ++i) { const int kk = 2 * i + (lane >> 5); scr[kk * 33 + (lane & 31)] = W[(size_t)(k0 + kk) * N + n0s + (lane & 31)]; }
    LDS_WAIT(); asm volatile("" ::: "memory");
    const int c = lane & 7;
#pragma unroll
    for (int j = 0; j < 4; ++j) { const int n = (lane >> 3) + 8 * j; const LAS float* s = scr + (8 * c) * 33 + n;
        v4u o; o.x = pk2(s[0 * 33], s[1 * 33]); o.y = pk2(s[2 * 33], s[3 * 33]); o.z = pk2(s[4 * 33], s[5 * 33]); o.w = pk2(s[6 * 33], s[7 * 33]);
        *(GAS v4u*)(WT + (size_t)(n0d + n) * K + k0 + 8 * c) = o; }
    LDS_WAIT(); asm volatile("" ::: "memory");
}

__device__ __forceinline__ void phase_p0(const Ctx& a, LAS unsigned char* lds, int tid, int lane, int wave, int bid, int G) {
    LAS float* sc = (LAS float*)lds;
    { const GAS float* cctx = a.in(6); const GAS float* cc = a.in(5);
      for (int i = tid; i < 9 * 1024; i += NTHREADS) { const int r = i >> 10, k = i & 1023; const float v = (r == 0) ? cctx[k] : cc[(r - 1) * 1024 + k]; sc[i] = v * sigmoid_f(v); } }
    __syncthreads();
    LAS float* red = (LAS float*)(lds + 40960);
    GAS float* MOD = (GAS float*)(a.ws() + WS_MOD); const GAS float* wm = a.in(7); const GAS float* bm = a.in(8);
    for (int u = bid; u < 384; u += G) {
        const int l = u / 96, nb = u % 96;
        const int col = tid & 63, ks = tid >> 6, n = nb * 64 + col, k0 = ks * 128;
        const GAS float* w = wm + ((size_t)l * 1024 + k0) * 6144 + n;
        float acc[9];
#pragma unroll
        for (int r = 0; r < 9; ++r) acc[r] = 0.f;
#pragma unroll 4
        for (int k = 0; k < 128; ++k) { const float wv = w[(size_t)k * 6144];
#pragma unroll
            for (int r = 0; r < 9; ++r) acc[r] += sc[r * 1024 + k0 + k] * wv; }
#pragma unroll
        for (int r = 0; r < 9; ++r) red[(ks * 64 + col) * 9 + r] = acc[r];
        __syncthreads();
        for (int o = tid; o < 576; o += NTHREADS) { const int c = o / 9, r = o % 9; float sum = bm[l * 6144 + nb * 64 + c];
#pragma unroll
            for (int q = 0; q < 8; ++q) sum += red[(q * 64 + c) * 9 + r];
            MOD[((size_t)l * 9 + r) * 6144 + nb * 64 + c] = sum; }
        __syncthreads();
    }
    { GAS float* LOWER = (GAS float*)(a.ws() + WS_LOWER); const GAS float* hlb = a.in(16);
      for (int idx = bid * NTHREADS + tid; idx < 2048; idx += G * NTHREADS) {
          const float x0 = hlb[idx], x1 = hlb[2048 + idx], mx = fmaxf(x0, x1), e0 = expf(x0 - mx), e1 = expf(x1 - mx), s = e0 + e1, p0 = e0 / s, p1 = e1 / s;
          LOWER[idx] = fminf(fmaxf(p0 - p0, 0.f), 1.f); LOWER[2048 + idx] = fminf(fmaxf((p0 + p1) - p0, 0.f), 1.f); } }
    __syncthreads();
    LAS float* scr = (LAS float*)(lds + wave * 16384);
    const int gw = bid * NWAVES + wave, NGW = G * NWAVES;
    for (int it = gw; it < 27648; it += NGW) {
        int r = it;
        if (r < 3584) { const int e = r / 1792; transpose_item<false>(a.in(10) + (size_t)e * 1024 * NE_IN, 1024, NE_IN, (GAS bf16*)(a.ws() + WS_WTE_IN) + (size_t)e * NE_IN * 1024, scr, r % 1792, lane); continue; } r -= 3584;
        if (r < 1024) { const int e = r / 512; transpose_item<false>(a.in(11) + (size_t)e * 1048576, 1024, 1024, (GAS bf16*)(a.ws() + WS_WTE_OUT) + (size_t)e * 1048576, scr, r % 512, lane); continue; } r -= 1024;
        if (r < 5120) { const int o = r / 2560; transpose_item<false>(a.in(14) + (size_t)o * 1024 * NO_IN, 1024, NO_IN, (GAS bf16*)(a.ws() + WS_WTO_IN) + (size_t)o * NO_IN * 1024, scr, r % 2560, lane); continue; } r -= 5120;
        if (r < 1024) { const int o = r / 512; transpose_item<false>(a.in(15) + (size_t)o * 1048576, 1024, 1024, (GAS bf16*)(a.ws() + WS_WTO_OUT) + (size_t)o * 1048576, scr, r % 512, lane); continue; } r -= 1024;
        if (r < 11264) { const int l = r / 2816; transpose_item<true>(a.in(18) + (size_t)l * 1024 * NFF_IN, 1024, NFF_IN, (GAS bf16*)(a.ws() + WS_WTF_IN) + (size_t)l * NFF_IN * 1024, scr, r % 2816, lane); continue; } r -= 11264;
        { const int l = r / 1408; transpose_item<false>(a.in(19) + (size_t)l * DFF * 1024, DFF, 1024, (GAS bf16*)(a.ws() + WS_WTF_OUT) + (size_t)l * 1024 * DFF, scr, r % 1408, lane); }
    }
}

__device__ __forceinline__ void phase_rowpass(const Ctx& a, int l, int mode, int lane, int gw, int NGW) {
    GAS float* X = a.out(); const GAS float* Mb = (const GAS float*)(a.ws() + WS_M); GAS bf16* H = (GAS bf16*)(a.ws() + WS_H); const GAS float* MOD = (const GAS float*)(a.ws() + WS_MOD); const GAS float* ng = a.in(9); const GAS float* xin0 = a.in(0); const GAS float* xin1 = a.in(1);
    const GAS float* g_a = ng + (size_t)(l * 4 + (mode == 1 ? 1 : 3)) * 1024;
    const int gt_off = (mode == 1) ? 2048 : 5120;
    const int lh = (mode == 2) ? l + 1 : l;
    const bool doH = !(mode == 2 && l == 3);
    const GAS float* g_b = ng + (size_t)((doH ? lh : 0) * 4 + (mode == 1 ? 2 : 0)) * 1024;
    const int sh_off = (mode == 1) ? 3072 : 0, sc_off = (mode == 1) ? 4096 : 1024;
    for (int row = gw; row < MROWS; row += NGW) {
        const int bidx = row < MP ? 0 : 1 + ((row - MP) >> 10);
        const GAS float* modl = MOD + ((size_t)l * 9 + bidx) * 6144;
        const GAS float* modh = MOD + ((size_t)(doH ? lh : 0) * 9 + bidx) * 6144;
        const GAS float* xsrc = (mode == 0) ? (row < MP ? xin0 + (size_t)row * 1024 : xin1 + (size_t)(row - MP) * 1024) : X + (size_t)row * 1024;
        f32x4 xv[4];
#pragma unroll
        for (int j = 0; j < 4; ++j) xv[j] = *(const GAS f32x4*)(xsrc + lane * 4 + 256 * j);
        if (mode != 0) {
            f32x4 mv[4]; float ss = 0.f;
#pragma unroll
            for (int j = 0; j < 4; ++j) { mv[j] = *(const GAS f32x4*)(Mb + (size_t)row * 1024 + lane * 4 + 256 * j); ss += (mv[j].x * mv[j].x + mv[j].y * mv[j].y) + (mv[j].z * mv[j].z + mv[j].w * mv[j].w); }
            const float rstd = rsqrtf(wave_sum(ss) * (1.f / 1024.f) + EPS_N);
#pragma unroll
            for (int j = 0; j < 4; ++j) { const f32x4 ga = *(const GAS f32x4*)(g_a + lane * 4 + 256 * j), gt = *(const GAS f32x4*)(modl + gt_off + lane * 4 + 256 * j);
                xv[j] = xv[j] + gt * (mv[j] * rstd * ga); }
        }
#pragma unroll
        for (int j = 0; j < 4; ++j) *(GAS f32x4*)(X + (size_t)row * 1024 + lane * 4 + 256 * j) = xv[j];
        if (doH) {
            float ss = 0.f;
#pragma unroll
            for (int j = 0; j < 4; ++j) ss += (xv[j].x * xv[j].x + xv[j].y * xv[j].y) + (xv[j].z * xv[j].z + xv[j].w * xv[j].w);
            const float rstd = rsqrtf(wave_sum(ss) * (1.f / 1024.f) + EPS_N);
#pragma unroll
            for (int j = 0; j < 4; ++j) { const f32x4 gb = *(const GAS f32x4*)(g_b + lane * 4 + 256 * j), sc = *(const GAS f32x4*)(modh + sc_off + lane * 4 + 256 * j), sh = *(const GAS f32x4*)(modh + sh_off + lane * 4 + 256 * j);
                const f32x4 hv = xv[j] * rstd * gb * (sc + 1.0f) + sh;
                *(GAS unsigned long long*)(H + (size_t)row * 1024 + lane * 4 + 256 * j) = (unsigned long long)pk2(hv.x, hv.y) | ((unsigned long long)pk2(hv.z, hv.w) << 32); }
        }
    }
}

struct SoftAcc { float m, l; float o[64]; };
__device__ __forceinline__ void soft_init(SoftAcc& s) { s.m = -INFINITY; s.l = 0.f;
#pragma unroll
    for (int d = 0; d < 64; ++d) s.o[d] = 0.f; }
#define CFENCE() asm volatile("" ::: "memory")
struct RowLds  { const LAS float* p; __device__ __forceinline__ f32x4 operator()(int c) const { return *(const LAS f32x4*)(p + 4 * c); } };
struct RowGf32 { const GAS float* p;     __device__ __forceinline__ f32x4 operator()(int c) const { return *(const GAS f32x4*)(p + 4 * c); } };
struct RowGbf  { const GAS bf16* p;      __device__ __forceinline__ f32x4 operator()(int c) const { const unsigned long long w = *(const GAS unsigned long long*)(p + 4 * c); const unsigned lo = (unsigned)w, hi = (unsigned)(w >> 32);
    return (f32x4){__uint_as_float(lo << 16), __uint_as_float(lo & 0xffff0000u), __uint_as_float(hi << 16), __uint_as_float(hi & 0xffff0000u)}; } };
template <class R> __device__ __forceinline__ float dot64(const float (&q)[64], const R& r, float init) {
    float sc = init;
#pragma unroll
    for (int c = 0; c < 16; ++c) { const f32x4 k = r(c); sc += q[4 * c] * k.x; sc += q[4 * c + 1] * k.y; sc += q[4 * c + 2] * k.z; sc += q[4 * c + 3] * k.w; if ((c & 3) == 3) CFENCE(); }
    return sc;
}
template <class R> __device__ __forceinline__ void soft_upd(SoftAcc& s, float sc, const R& r) {
    const float mn = fmaxf(s.m, sc), al = __expf(s.m - mn), p = __expf(sc - mn);
    s.l = s.l * al + p; s.m = mn;
#pragma unroll
    for (int c = 0; c < 16; ++c) { const f32x4 v = r(c); s.o[4 * c] = s.o[4 * c] * al + p * v.x; s.o[4 * c + 1] = s.o[4 * c + 1] * al + p * v.y; s.o[4 * c + 2] = s.o[4 * c + 2] * al + p * v.z; s.o[4 * c + 3] = s.o[4 * c + 3] * al + p * v.w; if ((c & 3) == 3) CFENCE(); }
}
__device__ __forceinline__ void soft_store(const SoftAcc& s, LAS float* p) { p[0] = s.m; p[1] = s.l;
#pragma unroll
    for (int d = 0; d < 64; ++d) p[2 + d] = s.o[d]; }
__device__ __forceinline__ void soft_merge(SoftAcc& s, const LAS float* p) {
    const float m2 = p[0], l2 = p[1], mn = fmaxf(s.m, m2), a1 = __expf(s.m - mn), a2 = __expf(m2 - mn);
    s.l = s.l * a1 + l2 * a2; s.m = mn;
#pragma unroll
    for (int d = 0; d < 64; ++d) s.o[d] = s.o[d] * a1 + p[2 + d] * a2;
}
__device__ __forceinline__ void load_row64_bf16(const GAS bf16* p, float (&f)[64]) {
#pragma unroll
    for (int c = 0; c < 8; ++c) { const v4u w = *(const GAS v4u*)(p + 8 * c); float t[8]; unpack8(w, t);
#pragma unroll
        for (int i = 0; i < 8; ++i) f[8 * c + i] = t[i]; }
}
__device__ __forceinline__ void store_row64_bf16(GAS bf16* p, const float (&f)[64], float scale) {
#pragma unroll
    for (int c = 0; c < 8; ++c) { v4u w; w.x = pk2(f[8 * c] * scale, f[8 * c + 1] * scale); w.y = pk2(f[8 * c + 2] * scale, f[8 * c + 3] * scale); w.z = pk2(f[8 * c + 4] * scale, f[8 * c + 5] * scale); w.w = pk2(f[8 * c + 6] * scale, f[8 * c + 7] * scale);
        *(GAS v4u*)(p + 8 * c) = w; }
}

__device__ __forceinline__ void ctx_attn_unit(const Ctx& a, LAS unsigned char* lds, int tid, int b, int h) {
    const GAS bf16* Z = (const GAS bf16*)(a.ws() + WS_Z); GAS bf16* O = (GAS bf16*)(a.ws() + WS_H);
    LAS float* sK = (LAS float*)lds; LAS float* sV = sK + 256 * 64;
    const size_t rb = (size_t)b * 256;
    for (int t = 0; t < 4; ++t) { const int idx = tid + NTHREADS * t, key = idx >> 3, ch = idx & 7; const GAS bf16* zr = Z + (rb + key) * NE_IN + h * 64 + ch * 8;
        float f[8]; unpack8(*(const GAS v4u*)(zr + 512), f);
        *(LAS f32x4*)(sK + key * 64 + ch * 8) = (f32x4){f[0], f[1], f[2], f[3]}; *(LAS f32x4*)(sK + key * 64 + ch * 8 + 4) = (f32x4){f[4], f[5], f[6], f[7]};
        unpack8(*(const GAS v4u*)(zr + 1024), f);
        *(LAS f32x4*)(sV + key * 64 + ch * 8) = (f32x4){f[0], f[1], f[2], f[3]}; *(LAS f32x4*)(sV + key * 64 + ch * 8 + 4) = (f32x4){f[4], f[5], f[6], f[7]}; }
    __syncthreads();
    const int q = tid & 255, half = tid >> 8;
    float qv[64]; load_row64_bf16(Z + (rb + q) * NE_IN + h * 64, qv);
#pragma unroll
    for (int d = 0; d < 64; ++d) qv[d] *= 0.125f;
    SoftAcc s; soft_init(s);
    for (int j = 0; j < 128; ++j) { const int key = half * 128 + j;
        const float sc = dot64(qv, RowLds{sK + key * 64}, 0.f);
        soft_upd(s, sc, RowLds{sV + key * 64}); }
    __syncthreads();
    LAS float* slot = (LAS float*)lds + q * 66;
    if (half == 1) soft_store(s, slot);
    __syncthreads();
    if (half == 0) { soft_merge(s, slot); store_row64_bf16(O + (rb + q) * 1024 + h * 64, s.o, 1.0f / s.l); }
    __syncthreads();
}

__device__ __forceinline__ void na_unit(const Ctx& a, LAS unsigned char* lds, int tid, int e, int b, int h, int r) {
    const GAS bf16* Z = (const GAS bf16*)(a.ws() + WS_Z); GAS bf16* O = (GAS bf16*)(a.ws() + WS_H);
    const int qc = tid & 63, p = tid >> 6;
    const size_t lb = (size_t)MP + (size_t)b * 1024;
    const int kr0 = min(max(r - 4, 0), 8), kr = kr0 + p, win0 = min(max(qc - 8, 0), 48);
    float qv[64]; load_row64_bf16(Z + (lb + r * 64 + qc) * NE_IN + h * 64, qv);
#pragma unroll
    for (int d = 0; d < 64; ++d) qv[d] *= 0.125f;
    const GAS float* rp = a.in(12) + ((size_t)(e * 8 + h) * 15 + (kr - r + 7)) * 31;
    SoftAcc s; soft_init(s);
    for (int j = 0; j < 16; ++j) { const int kc = win0 + j; const GAS bf16* zr = Z + (lb + kr * 64 + kc) * NE_IN + h * 64;
        const float sc = dot64(qv, RowGbf{zr + 512}, rp[kc - qc + 15]);
        soft_upd(s, sc, RowGbf{zr + 1024}); }
    const GAS float* ck = a.in(2) + ((((size_t)(b * 2 + e) * 2 + 0) * 8 + h) * 256) * 64;
    const GAS float* cv = a.in(2) + ((((size_t)(b * 2 + e) * 2 + 1) * 8 + h) * 256) * 64;
    for (int j = 0; j < 32; ++j) { const int kj = 32 * p + j;
        const float sc = dot64(qv, RowGf32{ck + (size_t)kj * 64}, 0.f);
        soft_upd(s, sc, RowGf32{cv + (size_t)kj * 64}); }
    LAS float* slots = (LAS float*)lds;
    if (p >= 4) soft_store(s, slots + ((p - 4) * 64 + qc) * 66);
    __syncthreads();
    if (p < 4) soft_merge(s, slots + (p * 64 + qc) * 66);
    __syncthreads();
    if (p == 2 || p == 3) soft_store(s, slots + ((p - 2) * 64 + qc) * 66);
    __syncthreads();
    if (p < 2) soft_merge(s, slots + (p * 64 + qc) * 66);
    __syncthreads();
    if (p == 1) soft_store(s, slots + qc * 66);
    __syncthreads();
    if (p == 0) { soft_merge(s, slots + qc * 66); store_row64_bf16(O + (lb + r * 64 + qc) * 1024 + h * 64, s.o, 1.0f / s.l); }
    __syncthreads();
}

__device__ __forceinline__ void ret_chain(const Ctx& a, LAS unsigned char* lds, int tid, int e, bool lat, int b, int h, int dir) {
    const GAS bf16* Z = (const GAS bf16*)(a.ws() + WS_Z); GAS bf16* OFB = (GAS bf16*)(a.ws() + WS_M + (dir ? 32 * MiB : 0));
    const int T = lat ? 1024 : 256; const size_t rowbase = lat ? (size_t)MP + (size_t)b * 1024 : (size_t)b * 256;
    const float g = expf(-expf(a.in(13)[(e * 2 + dir) * 8 + h]));
    const int v = tid & 63, dg = tid >> 6;
    float S[8]; const GAS float* s0p = a.in(3);
#pragma unroll
    for (int i = 0; i < 8; ++i) S[i] = lat ? s0p[((((size_t)(b * 2 + e) * 2 + dir) * 8 + h) * 64 + dg * 8 + i) * 64 + v] : 0.f;
    LAS float* sq = (LAS float*)lds; LAS float* sk = sq + 32 * 64; LAS float* sv = sk + 32 * 64; LAS float* part = sv + 32 * 64;
    const int ltok = tid >> 4, li = tid & 15;
    const float inv = exp2f(-(float)li * (13.287712379549449f / 16.0f));
    for (int c0 = 0; c0 < T; c0 += 32) {
        { const int st = c0 + ltok, n = dir ? T - 1 - st : st; const GAS bf16* zr = Z + (rowbase + n) * NE_IN + h * 64;
#pragma unroll
          for (int hf = 0; hf < 2; ++hf) {
              float q1 = bf2f(zr[1536 + hf * 32 + li]), q2 = bf2f(zr[1536 + hf * 32 + 16 + li]), k1 = bf2f(zr[2048 + hf * 32 + li]), k2 = bf2f(zr[2048 + hf * 32 + 16 + li]);
              if (lat) { const float pos = (float)(hf == 0 ? (n >> 6) : (n & 63)); float sn, cs; sincosf(pos * inv, &sn, &cs);
                  const float a1 = q1 * cs - q2 * sn, a2 = q1 * sn + q2 * cs, b1 = k1 * cs - k2 * sn, b2 = k1 * sn + k2 * cs; q1 = a1; q2 = a2; k1 = b1; k2 = b2; }
              sq[ltok * 64 + hf * 32 + li] = q1; sq[ltok * 64 + hf * 32 + 16 + li] = q2; sk[ltok * 64 + hf * 32 + li] = k1 * 0.125f; sk[ltok * 64 + hf * 32 + 16 + li] = k2 * 0.125f; }
#pragma unroll
          for (int j = 0; j < 4; ++j) sv[ltok * 64 + j * 16 + li] = bf2f(zr[2560 + j * 16 + li]); }
        __syncthreads();
        for (int j = 0; j < 32; ++j) {
            const float vv = sv[j * 64 + v];
            const f32x4 qa = *(const LAS f32x4*)(sq + j * 64 + dg * 8), qb = *(const LAS f32x4*)(sq + j * 64 + dg * 8 + 4), ka = *(const LAS f32x4*)(sk + j * 64 + dg * 8), kb = *(const LAS f32x4*)(sk + j * 64 + dg * 8 + 4);
            const float qq[8] = {qa.x, qa.y, qa.z, qa.w, qb.x, qb.y, qb.z, qb.w}, kk[8] = {ka.x, ka.y, ka.z, ka.w, kb.x, kb.y, kb.z, kb.w};
            float acc = 0.f;
#pragma unroll
            for (int i = 0; i < 8; ++i) { S[i] = g * S[i] + kk[i] * vv; acc += qq[i] * S[i]; }
            part[(j * 8 + dg) * 64 + v] = acc; }
        __syncthreads();
#pragma unroll
        for (int t = 0; t < 4; ++t) { const int idx = tid + NTHREADS * t, tok = idx >> 6, vv = idx & 63; float sum = 0.f;
#pragma unroll
            for (int d8 = 0; d8 < 8; ++d8) sum += part[(tok * 8 + d8) * 64 + vv];
            const int st = c0 + tok, n = dir ? T - 1 - st : st;
            OFB[(rowbase + n) * 1024 + h * 64 + vv] = f2bf16(sum); }
        __syncthreads();
    }
    if (!lat) { GAS float* SR = a.out() + OUT_SR;
#pragma unroll
        for (int i = 0; i < 8; ++i) SR[((((size_t)(b * 2 + e) * 2 + dir) * 8 + h) * 64 + dg * 8 + i) * 64 + v] = S[i]; }
}

__device__ __forceinline__ void hgrn_chain(const Ctx& a, LAS unsigned char* lds, int tid, int oi, bool lat, int b, int h, int dir) {
    const GAS bf16* Z = (const GAS bf16*)(a.ws() + WS_Z); GAS bf16* OFB = (GAS bf16*)(a.ws() + WS_M + (dir ? 32 * MiB : 0));
    const int T = lat ? 1024 : 256; const size_t rowbase = lat ? (size_t)MP + (size_t)b * 1024 : (size_t)b * 256;
    const GAS float* lower = (const GAS float*)(a.ws() + WS_LOWER) + (size_t)(oi * 2 + dir) * 1024 + h * 128;
    const int v = tid & 127, dg = tid >> 7;
    float S[32]; const GAS float* s0p = a.in(4);
#pragma unroll
    for (int i = 0; i < 32; ++i) S[i] = lat ? s0p[((((size_t)(b * 2 + oi) * 2 + dir) * 8 + h) * 128 + dg * 32 + i) * 128 + v] : 0.f;
    LAS float* sq = (LAS float*)lds; LAS float* sf = sq + 16 * 128; LAS float* sk = sf + 16 * 128; LAS float* sv = sk + 16 * 128; LAS float* part = sv + 16 * 128;
    for (int c0 = 0; c0 < T; c0 += 16) {
#pragma unroll
        for (int t = 0; t < 4; ++t) { const int idx = tid + NTHREADS * t, tok = idx >> 7, d = idx & 127; const int st = c0 + tok, n = dir ? T - 1 - st : st;
            const GAS bf16* zr = Z + (rowbase + n) * NO_IN + h * 128 + d;
            const float qr = bf2f(zr[0]), fr = bf2f(zr[1024 + dir * 1024]), vi = bf2f(zr[3072]), lbv = lower[d];
            const float sg = sigmoid_f(fr), sgn = sigmoid_f(-fr);
            sq[idx] = qr * sigmoid_f(qr) * 0.08838834764831845f; sf[idx] = fmaxf(lbv + (1.f - lbv) * sg, 1e-30f); sk[idx] = (1.f - lbv) * sgn; sv[idx] = vi; }
        __syncthreads();
        for (int j = 0; j < 16; ++j) {
            const float vv = sv[j * 128 + v]; float acc = 0.f;
#pragma unroll
            for (int c = 0; c < 8; ++c) { const f32x4 f4 = *(const LAS f32x4*)(sf + j * 128 + dg * 32 + 4 * c), k4 = *(const LAS f32x4*)(sk + j * 128 + dg * 32 + 4 * c), q4 = *(const LAS f32x4*)(sq + j * 128 + dg * 32 + 4 * c);
                S[4 * c] = f4.x * S[4 * c] + k4.x * vv; acc += q4.x * S[4 * c];
                S[4 * c + 1] = f4.y * S[4 * c + 1] + k4.y * vv; acc += q4.y * S[4 * c + 1];
                S[4 * c + 2] = f4.z * S[4 * c + 2] + k4.z * vv; acc += q4.z * S[4 * c + 2];
                S[4 * c + 3] = f4.w * S[4 * c + 3] + k4.w * vv; acc += q4.w * S[4 * c + 3]; }
            part[(j * 4 + dg) * 128 + v] = acc; }
        __syncthreads();
#pragma unroll
        for (int t = 0; t < 4; ++t) { const int idx = tid + NTHREADS * t, tok = idx >> 7, vv = idx & 127;
            const float sum = (part[(tok * 4 + 0) * 128 + vv] + part[(tok * 4 + 1) * 128 + vv]) + (part[(tok * 4 + 2) * 128 + vv] + part[(tok * 4 + 3) * 128 + vv]);
            const int st = c0 + tok, n = dir ? T - 1 - st : st;
            OFB[(rowbase + n) * 1024 + h * 128 + vv] = f2bf16(sum); }
        __syncthreads();
    }
    if (!lat) { GAS float* SH = a.out() + OUT_SH;
#pragma unroll
        for (int i = 0; i < 32; ++i) SH[((((size_t)(b * 2 + oi) * 2 + dir) * 8 + h) * 128 + dg * 32 + i) * 128 + v] = S[i]; }
}

typedef short s16x4 __attribute__((ext_vector_type(4)));
typedef short v4i16_t __attribute__((ext_vector_type(4)));
typedef float f32x16 __attribute__((ext_vector_type(16)));
#define MFMA32(a, b, c) __builtin_amdgcn_mfma_f32_32x32x16_bf16((a), (b), (c), 0, 0, 0)
__device__ __forceinline__ int crow(int r, int hi) { return (r & 3) + 8 * (r >> 2) + 4 * hi; }
__device__ __forceinline__ s16x4 ld_tr(const LAS bf16* p) { return __builtin_bit_cast(s16x4, __builtin_amdgcn_ds_read_tr16_b64_v4i16((LAS v4i16_t*)p)); }
__device__ __forceinline__ bf16x8 frag_row(const LAS bf16* img, int stride, int idx0, int k0, int lane) { return *(const LAS bf16x8*)(img + (idx0 + (lane & 31)) * stride + k0 + 8 * (lane >> 5)); }
__device__ __forceinline__ bf16x8 frag_tr(const LAS bf16* img, int stride, int k0, int idx0, int lane) {
    const int hi = lane >> 5, blk = (lane >> 4) & 1, q = (lane & 15) >> 2, p = lane & 3;
    const LAS bf16* a = img + (k0 + 8 * hi + q) * stride + idx0 + 16 * blk + 4 * p;
    const s16x4 lo = ld_tr(a), hh = ld_tr(a + 4 * stride);
    return (bf16x8){lo[0], lo[1], lo[2], lo[3], hh[0], hh[1], hh[2], hh[3]};
}
__device__ __forceinline__ bf16x8 frag_tr_perm(const LAS bf16* img, int stride, int k0, int idx0, int lane) {
    const int hi = lane >> 5, blk = (lane >> 4) & 1, q = (lane & 15) >> 2, p = lane & 3;
    const LAS bf16* a = img + (k0 + 4 * hi + q) * stride + idx0 + 16 * blk + 4 * p;
    const s16x4 lo = ld_tr(a), hh = ld_tr(a + 8 * stride);
    return (bf16x8){lo[0], lo[1], lo[2], lo[3], hh[0], hh[1], hh[2], hh[3]};
}
__device__ __forceinline__ unsigned pkbf(float lo, float hi) { typedef float f2 __attribute__((ext_vector_type(2))); typedef __bf16 b2 __attribute__((ext_vector_type(2))); const f2 v = {lo, hi}; const b2 b = __builtin_convertvector(v, b2); return __builtin_bit_cast(unsigned, b); }
__device__ __forceinline__ f32x16 zero16() { f32x16 z;
#pragma unroll
    for (int i = 0; i < 16; ++i) z[i] = 0.f; return z; }

constexpr int HG_RS = 136, HG_PS = 72;
constexpr int HG_QH = 0, HG_KH = HG_QH + 64 * HG_RS * 2, HG_V = HG_KH + 64 * HG_RS * 2, HG_SI = HG_V + 64 * HG_RS * 2, HG_P = HG_SI + 128 * HG_RS * 2, HG_BM = HG_P + 64 * HG_PS * 2, HG_BL = HG_BM + 512, HG_QT = HG_BL + 512, HG_END = HG_QT + 2048;
static_assert(HG_END <= RING_BYTES, "HGRN LDS map");
__device__ __forceinline__ float clamp80(float x) { return fminf(fmaxf(x, -80.f), 80.f); }
__device__ __forceinline__ void hgrn_chain_mfma(const Ctx& a, LAS unsigned char* lds, int tid, int oi, bool lat, int b, int h, int dir) {
    const GAS bf16* Z = (const GAS bf16*)(a.ws() + WS_Z); GAS bf16* OFB = (GAS bf16*)(a.ws() + WS_M + (dir ? 32 * MiB : 0));
    const int T = lat ? 1024 : 256; const size_t rowbase = lat ? (size_t)MP + (size_t)b * 1024 : (size_t)b * 256;
    const int lane = tid & 63, w = __builtin_amdgcn_readfirstlane(tid >> 6), hi = lane >> 5, l31 = lane & 31;
    LAS bf16* QH = (LAS bf16*)(lds + HG_QH); LAS bf16* KH = (LAS bf16*)(lds + HG_KH); LAS bf16* VV = (LAS bf16*)(lds + HG_V); LAS bf16* SI = (LAS bf16*)(lds + HG_SI); LAS bf16* PP = (LAS bf16*)(lds + HG_P);
    LAS float* BM = (LAS float*)(lds + HG_BM); LAS float* BL = (LAS float*)(lds + HG_BL); LAS float* QT = (LAS float*)(lds + HG_QT);
    const int d = tid & 127, qtr = tid >> 7;
    const float lbv = ((const GAS float*)(a.ws() + WS_LOWER))[(size_t)(oi * 2 + dir) * 1024 + h * 128 + d];
    const int dkb = w & 3, dvb0 = 2 * (w >> 2);
    f32x16 S0, S1;
    if (lat) { const GAS float* s0p = a.in(4) + ((((size_t)(b * 2 + oi) * 2 + dir) * 8 + h) * 128 + 32 * dkb + l31) * 128;
#pragma unroll
        for (int g = 0; g < 4; ++g) { const f32x4 x0 = *(const GAS f32x4*)(s0p + 32 * dvb0 + 8 * g + 4 * hi), x1 = *(const GAS f32x4*)(s0p + 32 * (dvb0 + 1) + 8 * g + 4 * hi);
            S0[4 * g] = x0.x; S0[4 * g + 1] = x0.y; S0[4 * g + 2] = x0.z; S0[4 * g + 3] = x0.w; S1[4 * g] = x1.x; S1[4 * g + 1] = x1.y; S1[4 * g + 2] = x1.z; S1[4 * g + 3] = x1.w; }
    } else { S0 = zero16(); S1 = zero16(); }
    for (int c0 = 0; c0 < T; c0 += 64) {
        float qv[16], kv[16], cb[16]; float run = 0.f;
#pragma unroll
        for (int i = 0; i < 16; ++i) { const int st = c0 + 16 * qtr + i, n = dir ? T - 1 - st : st; const GAS bf16* zr = Z + (rowbase + n) * NO_IN + h * 128 + d;
            const float qr = bf2f(zr[0]), fr = bf2f(zr[1024 + dir * 1024]); const unsigned short vraw = zr[3072];
            const float sg = sigmoid_f(fr), f = fmaxf(lbv + (1.f - lbv) * sg, 1e-30f);
            run += __logf(f); cb[i] = run; kv[i] = (1.f - lbv) * sigmoid_f(-fr); qv[i] = qr * sigmoid_f(qr) * 0.08838834764831845f;
            VV[(16 * qtr + i) * HG_RS + d] = vraw; }
        QT[qtr * 128 + d] = run;
        __syncthreads();
        const float t0 = QT[d], t1 = QT[128 + d], t2 = QT[256 + d], t3 = QT[384 + d];
        const float off = (qtr > 0 ? t0 : 0.f) + (qtr > 1 ? t1 : 0.f) + (qtr > 2 ? t2 : 0.f), bmid = t0 + t1, blast = (t0 + t1) + (t2 + t3);
#pragma unroll
        for (int i = 0; i < 16; ++i) { const float bt = off + cb[i]; const int t = 16 * qtr + i;
            QH[t * HG_RS + d] = f2bf16(qv[i] * __expf(clamp80(bt - bmid))); KH[t * HG_RS + d] = f2bf16(kv[i] * __expf(clamp80(bmid - bt))); }
        if (qtr == 0) { BM[d] = bmid; BL[d] = blast; }
        __syncthreads();
        const float bm_l = BM[32 * dkb + l31], bl_l = BL[32 * dkb + l31], em = __expf(clamp80(bm_l));
#pragma unroll
        for (int g = 0; g < 4; ++g) {
            *(LAS unsigned long long*)(SI + (32 * dkb + l31) * HG_RS + 32 * dvb0 + 8 * g + 4 * hi) = (unsigned long long)pkbf(S0[4 * g] * em, S0[4 * g + 1] * em) | ((unsigned long long)pkbf(S0[4 * g + 2] * em, S0[4 * g + 3] * em) << 32);
            *(LAS unsigned long long*)(SI + (32 * dkb + l31) * HG_RS + 32 * (dvb0 + 1) + 8 * g + 4 * hi) = (unsigned long long)pkbf(S1[4 * g] * em, S1[4 * g + 1] * em) | ((unsigned long long)pkbf(S1[4 * g + 2] * em, S1[4 * g + 3] * em) << 32); }
        { f32x16 u0 = zero16(), u1 = zero16();
#pragma unroll
          for (int ks = 0; ks < 4; ++ks) { const bf16x8 bk = frag_tr(KH, HG_RS, 16 * ks, 32 * dkb, lane);
              u0 = MFMA32(frag_tr(VV, HG_RS, 16 * ks, 32 * dvb0, lane), bk, u0); u1 = MFMA32(frag_tr(VV, HG_RS, 16 * ks, 32 * (dvb0 + 1), lane), bk, u1); }
          const float e1 = __expf(clamp80(bl_l)), e2 = __expf(clamp80(bl_l - bm_l));
#pragma unroll
          for (int r = 0; r < 16; ++r) { S0[r] = S0[r] * e1 + u0[r] * e2; S1[r] = S1[r] * e1 + u1[r] * e2; } }
        if (w < 3) { const int tb = (w == 0) ? 0 : 1, sb = (w == 2) ? 1 : 0; f32x16 p = zero16();
#pragma unroll
            for (int ks = 0; ks < 8; ++ks) p = MFMA32(frag_row(KH, HG_RS, 32 * sb, 16 * ks, lane), frag_row(QH, HG_RS, 32 * tb, 16 * ks, lane), p);
            const int t = 32 * tb + l31;
#pragma unroll
            for (int g = 0; g < 4; ++g) { float x[4];
#pragma unroll
                for (int i = 0; i < 4; ++i) { const int s = 32 * sb + 8 * g + 4 * hi + i; x[i] = (s <= t) ? p[4 * g + i] : 0.f; }
                *(LAS unsigned long long*)(PP + t * HG_PS + 32 * sb + 8 * g + 4 * hi) = (unsigned long long)pkbf(x[0], x[1]) | ((unsigned long long)pkbf(x[2], x[3]) << 32); } }
        __syncthreads();
        { const int tb = w & 1, dvb = w >> 1; f32x16 o = zero16();
#pragma unroll
          for (int ks = 0; ks < 8; ++ks) o = MFMA32(frag_row(QH, HG_RS, 32 * tb, 16 * ks, lane), frag_tr(SI, HG_RS, 16 * ks, 32 * dvb, lane), o);
          const int nks = tb ? 4 : 2;
          for (int ks = 0; ks < nks; ++ks) o = MFMA32(frag_row(PP, HG_PS, 32 * tb, 16 * ks, lane), frag_tr(VV, HG_RS, 16 * ks, 32 * dvb, lane), o);
#pragma unroll
          for (int r = 0; r < 16; ++r) { const int st = c0 + 32 * tb + crow(r, hi), n = dir ? T - 1 - st : st;
              OFB[(rowbase + n) * 1024 + h * 128 + 32 * dvb + l31] = f2bf16(o[r]); } }
        __syncthreads();
    }
    if (!lat) { GAS float* sp = a.out() + OUT_SH + ((((size_t)(b * 2 + oi) * 2 + dir) * 8 + h) * 128 + 32 * dkb + l31) * 128;
#pragma unroll
        for (int g = 0; g < 4; ++g) { *(GAS f32x4*)(sp + 32 * dvb0 + 8 * g + 4 * hi) = (f32x4){S0[4 * g], S0[4 * g + 1], S0[4 * g + 2], S0[4 * g + 3]};
            *(GAS f32x4*)(sp + 32 * (dvb0 + 1) + 8 * g + 4 * hi) = (f32x4){S1[4 * g], S1[4 * g + 1], S1[4 * g + 2], S1[4 * g + 3]}; } }
}

__device__ __forceinline__ void phase_mix_even(const Ctx& a, LAS unsigned char* lds, int tid, int bid, int G, int e) {
    for (int s = bid; s < 256; s += G) {
        if (s < 128) ret_chain(a, lds, tid, e, true, s >> 4, (s >> 1) & 7, s & 1);
        else for (int j = 0; j < 4; ++j) { const int pc = (s - 128) * 4 + j; ret_chain(a, lds, tid, e, false, pc >> 4, (pc >> 1) & 7, pc & 1); } }
    for (int u = bid; u < 256; u += G) ctx_attn_unit(a, lds, tid, u >> 3, u & 7);
    for (int u = bid; u < 1024; u += G) na_unit(a, lds, tid, e, u >> 7, (u >> 4) & 7, u & 15);
}
__device__ __forceinline__ void phase_mix_odd(const Ctx& a, LAS unsigned char* lds, int tid, int bid, int G, int oi) {
    for (int s = bid; s < 256; s += G) {
        if (s < 128) hgrn_chain_mfma(a, lds, tid, oi, true, s >> 4, (s >> 1) & 7, s & 1);
        else for (int j = 0; j < 4; ++j) { const int pc = (s - 128) * 4 + j; hgrn_chain_mfma(a, lds, tid, oi, false, pc >> 4, (pc >> 1) & 7, pc & 1); } }
}
__device__ __forceinline__ void phase_fin(const Ctx& a, int l, int lane, int gw, int NGW) {
    const GAS bf16* Z = (const GAS bf16*)(a.ws() + WS_Z); const GAS bf16* OF = (const GAS bf16*)(a.ws() + WS_M); const GAS bf16* OB = (const GAS bf16*)(a.ws() + WS_M + 32 * MiB); GAS bf16* O = (GAS bf16*)(a.ws() + WS_H);
    const int head = lane >> 3, sub = lane & 7;
    if ((l & 1) == 0) {
        for (int row = gw; row < MROWS; row += NGW) { const int c0 = head * 64 + sub * 8;
            float f1[8], f2[8], gg[8]; unpack8(*(const GAS v4u*)(OF + (size_t)row * 1024 + c0), f1); unpack8(*(const GAS v4u*)(OB + (size_t)row * 1024 + c0), f2); unpack8(*(const GAS v4u*)(Z + (size_t)row * NE_IN + 3072 + c0), gg);
            float ss = 0.f;
#pragma unroll
            for (int i = 0; i < 8; ++i) { f1[i] += f2[i]; ss += f1[i] * f1[i]; }
            ss += __shfl_xor(ss, 1); ss += __shfl_xor(ss, 2); ss += __shfl_xor(ss, 4);
            const float rstd = rsqrtf(ss * (1.f / 64.f) + EPS_N);
#pragma unroll
            for (int i = 0; i < 8; ++i) f1[i] = f1[i] * rstd * (gg[i] * sigmoid_f(gg[i]));
            v4u w; w.x = pk2(f1[0], f1[1]); w.y = pk2(f1[2], f1[3]); w.z = pk2(f1[4], f1[5]); w.w = pk2(f1[6], f1[7]);
            *(GAS v4u*)(O + (size_t)row * 1024 + 512 + c0) = w; }
    } else {
        const int oi = l >> 1; const GAS float* gn = a.in(17) + oi * 128 + sub * 16;
        for (int row = gw; row < MROWS; row += NGW) { const int c0 = head * 128 + sub * 16;
            float f[16]; float ss = 0.f;
#pragma unroll
            for (int hh = 0; hh < 2; ++hh) { float f1[8], f2[8]; unpack8(*(const GAS v4u*)(OF + (size_t)row * 1024 + c0 + 8 * hh), f1); unpack8(*(const GAS v4u*)(OB + (size_t)row * 1024 + c0 + 8 * hh), f2);
#pragma unroll
                for (int i = 0; i < 8; ++i) { f[8 * hh + i] = f1[i] + f2[i]; ss += f[8 * hh + i] * f[8 * hh + i]; } }
            ss += __shfl_xor(ss, 1); ss += __shfl_xor(ss, 2); ss += __shfl_xor(ss, 4);
            const float rstd = rsqrtf(ss * (1.f / 128.f) + EPS_N);
#pragma unroll
            for (int hh = 0; hh < 2; ++hh) { float gg[8]; unpack8(*(const GAS v4u*)(Z + (size_t)row * NO_IN + 4096 + c0 + 8 * hh), gg); float o8[8];
#pragma unroll
                for (int i = 0; i < 8; ++i) o8[i] = f[8 * hh + i] * rstd * gn[8 * hh + i] * (gg[i] * sigmoid_f(gg[i]));
                v4u w; w.x = pk2(o8[0], o8[1]); w.y = pk2(o8[2], o8[3]); w.z = pk2(o8[4], o8[5]); w.w = pk2(o8[6], o8[7]);
                *(GAS v4u*)(O + (size_t)row * 1024 + c0 + 8 * hh) = w; } }
    }
}

constexpr int NPHASES = 34;
__global__ void __launch_bounds__(NTHREADS, 2) mk_fwd(Args args) {
    extern __shared__ __attribute__((aligned(16))) unsigned char lds_raw[];
    LAS unsigned char* lds = (LAS unsigned char*)lds_raw;
    const int tid = threadIdx.x, bid = blockIdx.x, G = gridDim.x, NGW = G * NWAVES;
    volatile LAS unsigned* MISC = (volatile LAS unsigned*)(lds + MISC_OFF);
    for (int u = tid; u < (LDS_BYTES - LDSCTL_OFF) / 4; u += NTHREADS) ((LAS unsigned*)(lds + LDSCTL_OFF))[u] = 0u;
    __syncthreads();
    if (tid == 0) { LAS unsigned long long* t = (LAS unsigned long long*)(lds + LDSCTL_OFF);
#pragma unroll
        for (int i = 0; i < 20; ++i) t[i] = (unsigned long long)args.in[i];
        t[20] = (unsigned long long)args.out; t[21] = (unsigned long long)args.ws; }
    __syncthreads();
    const Ctx ctx{lds};
    const int ph_lo = args.ph_lo, ph_hi = args.ph_hi;
    (void)xcd_barrier_post((unsigned*)((gu32*)(ctx.ws() + WS_CTL) + CW_BAR), MISC + 8);
    const int tid0 = tid, bid0 = bid;
    for (int ph = ph_lo, prep = 0; ph < ph_hi; ++ph) {
        const Ctx& args = ctx;
        int tid = tid0, bid = bid0; asm volatile("" : "+v"(tid)); asm volatile("" : "+s"(bid));
        const int lane = tid & 63, wave = __builtin_amdgcn_readfirstlane(tid >> 6), gw = bid * NWAVES + wave;
        if (ph == 0) phase_p0(args, lds, tid, lane, wave, bid, G);
        else if (ph == 1) phase_rowpass(args, 0, 0, lane, gw, NGW);
        else {
            const int l = (ph - 2) >> 3, sub = (ph - 2) & 7, e = l >> 1;
            const GAS bf16* Hb = (const GAS bf16*)(args.ws() + WS_H); GAS bf16* Zb = (GAS bf16*)(args.ws() + WS_Z); GAS float* Mb = (GAS float*)(args.ws() + WS_M);
            if (sub == 0) {
                if ((l & 1) == 0) { pg8::Gemm g{Hb, (const GAS bf16*)(args.ws() + WS_WTE_IN) + (size_t)e * NE_IN * 1024, MROWS, NE_IN, 1024}; pg8::StaticOrder S; S.init(MROWS, NE_IN, G, bid);
                    pg8::EpiZ E{Zb, NE_IN, args.out() + OUT_KV, e}; pg8::gemm_phase<pg8::EpiZ, pg8::StaticOrder, true, true>(lds, g, S, E); }
                else { pg8::Gemm g{Hb, (const GAS bf16*)(args.ws() + WS_WTO_IN) + (size_t)e * NO_IN * 1024, MROWS, NO_IN, 1024}; pg8::StaticOrder S; S.init(MROWS, NO_IN, G, bid);
                    pg8::EpiZ E{Zb, NO_IN, nullptr, 0}; pg8::gemm_phase<pg8::EpiZ, pg8::StaticOrder, true, true>(lds, g, S, E); }
            } else if (sub == 1) {
                if ((l & 1) == 0) phase_mix_even(args, lds, tid, bid, G, e); else phase_mix_odd(args, lds, tid, bid, G, e);
            } else if (sub == 2) phase_fin(args, l, lane, gw, NGW);
            else if (sub == 3) {
                const GAS bf16* Wt = ((l & 1) == 0) ? (const GAS bf16*)(args.ws() + WS_WTE_OUT) + (size_t)e * 1048576 : (const GAS bf16*)(args.ws() + WS_WTO_OUT) + (size_t)e * 1048576;
                pg8::Gemm g{Hb, Wt, MROWS, 1024, 1024}; pg8::StaticOrder S; S.init(MROWS, 1024, G, bid);
                pg8::EpiF32 E{Mb, 1024}; pg8::gemm_phase<pg8::EpiF32, pg8::StaticOrder, true, true>(lds, g, S, E);
            } else if (sub == 4) phase_rowpass(args, l, 1, lane, gw, NGW);
            else if (sub == 5) {
                pg8::Gemm g{Hb, (const GAS bf16*)(args.ws() + WS_WTF_IN) + (size_t)l * NFF_IN * 1024, MROWS, NFF_IN, 1024}; pg8::StaticOrder S; S.init(MROWS, NFF_IN, G, bid);
                pg8::EpiSwiglu E{Zb, DFF}; pg8::gemm_phase<pg8::EpiSwiglu, pg8::StaticOrder, true, true>(lds, g, S, E);
            } else if (sub == 6) {
                pg8::Gemm g{Zb, (const GAS bf16*)(args.ws() + WS_WTF_OUT) + (size_t)l * 1024 * DFF, MROWS, 1024, DFF}; pg8::StaticOrder S; S.init(MROWS, 1024, G, bid);
                pg8::EpiF32 E{Mb, 1024}; pg8::gemm_phase<pg8::EpiF32, pg8::StaticOrder, true, true>(lds, g, S, E);
            } else phase_rowpass(args, l, 2, lane, gw, NGW);
        }
        if (ph + 1 < ph_hi) { XcdBarrier bar; bar.bar = (unsigned*)((gu32*)(ctx.ws() + WS_CTL) + CW_BAR); bar.x = xb_xcc_id(); bar.st = MISC + 8; xcd_barrier(bar); }
#ifdef PROBE_MASK
        { const int sub_ = (ph - 2) & 7, l_ = (ph - 2) >> 3; int cat = -1;
          if (ph == 0) cat = 4; else if (ph >= 2) { if (sub_ == 0 || sub_ == 3 || sub_ == 5 || sub_ == 6) cat = 0; else if (sub_ == 1) cat = (l_ & 1) ? 2 : 1; else if (sub_ == 2) cat = 3; }
          if (cat >= 0 && ((PROBE_MASK >> cat) & 1) && prep == 0) { prep = 1; --ph; } else prep = 0; }
#endif
    }
}

extern "C" void kernel_launch(void* const* d_in, const int* in_sizes, int n_in, void* d_out, int out_size, void* d_ws, size_t ws_size, hipStream_t stream) {
    static int grid = 0;
    if (grid == 0) {
        if (n_in != 20 || ws_size < WS_END) { fprintf(stderr, "kernel_launch: need 20 inputs and >= %zu bytes of workspace; got n_in %d, ws %zu\n", (size_t)WS_END, n_in, ws_size); grid = -1; return; }
        int dev = 0, cus = 0, per_cu = 0;
        if (hipGetDevice(&dev) != hipSuccess || hipDeviceGetAttribute(&cus, hipDeviceAttributeMultiprocessorCount, dev) != hipSuccess) { fprintf(stderr, "kernel_launch: device query failed\n"); grid = -1; return; }
        if (hipFuncSetAttribute((const void*)mk_fwd, hipFuncAttributeMaxDynamicSharedMemorySize, LDS_BYTES) != hipSuccess) { fprintf(stderr, "kernel_launch: hipFuncSetAttribute failed\n"); grid = -1; return; }
        if (hipOccupancyMaxActiveBlocksPerMultiprocessor(&per_cu, (const void*)mk_fwd, NTHREADS, LDS_BYTES) != hipSuccess || per_cu < 1) { fprintf(stderr, "kernel_launch: occupancy query reports %d blocks per CU\n", per_cu); per_cu = 1; }
        (void)hipGetLastError();
        grid = cus;
    }
    if (grid < 0) return;
    (void)hipMemsetAsync((char*)d_ws + WS_CTL, 0, CTL_ZERO_BYTES, stream);
    Args a{};
    for (int i = 0; i < 20; ++i) a.in[i] = (const float*)d_in[i];
    a.out = (float*)d_out; a.ws = (unsigned char*)d_ws;
#if MK_PER_PHASE
    for (int ph = 0; ph < NPHASES; ++ph) { a.ph_lo = ph; a.ph_hi = ph + 1; hipLaunchKernelGGL(mk_fwd, dim3(grid), dim3(NTHREADS), LDS_BYTES, stream, a); }
#else
    a.ph_lo = 0; a.ph_hi = NPHASES;
    void* params[] = {&a};
    hipError_t e = hipLaunchCooperativeKernel((const void*)mk_fwd, dim3(grid), dim3(NTHREADS), params, LDS_BYTES, stream);
    if (e != hipSuccess) fprintf(stderr, "kernel_launch: cooperative launch failed: %s (grid %d)\n", hipGetErrorString(e), grid);
#endif
}
```

```cpp
#include <hip/hip_runtime.h>
#include <cstdio>
#include <cstdint>
#include <cmath>
#ifndef MK_PER_PHASE
#define MK_PER_PHASE 0
#endif
namespace pg8 {
#define PG8_LAS __attribute__((address_space(3)))
#define PG8_GAS __attribute__((address_space(1)))
typedef unsigned short bf16_t;
typedef short bf16x8 __attribute__((ext_vector_type(8)));
typedef float f32x4 __attribute__((ext_vector_type(4)));
typedef unsigned u32x4 __attribute__((ext_vector_type(4)));
constexpr int BM = 256, BK = 64, HALF = 128, HTB = HALF * BK * 2  , STAGE_BYTES = 8 * HTB, NXCD = 8, WGM = 8;

__host__ __device__ __forceinline__ int lds_byte(int r, int c) { const int st = (r >> 4) * 2 + (c >> 5), rr = r & 15, cc = c & 31, ob = rr * 64 + cc * 2; return st * 1024 + (ob ^ (((ob >> 9) & 1) << 5)); }
__host__ __device__ __forceinline__ void stage_rc(int b, int& R, int& C) { const int st = b / 1024, sb = b % 1024, swz = sb ^ (((sb >> 9) & 1) << 5); R = (st >> 1) * 16 + swz / 64; C = (st & 1) * 32 + (swz % 64) / 2; }
__host__ __device__ __forceinline__ int perm32(int rho) { const int n = rho >> 4, i = rho & 15; return 8 * (i >> 2) + 4 * n + (i & 3); }

struct Unit { int pm, pn; };
struct Gemm { const PG8_GAS bf16_t* A; const PG8_GAS bf16_t* Bt; int M, N, K; };

struct StaticOrder {
    int nM, nN, nwg, G, c;
    __host__ __device__ void init(int M, int N, int G_, int c_) { nM = M / BM; nN = N / BM; nwg = nM * nN; G = G_; c = c_; }
    __host__ __device__ bool next(int i, Unit& u) const {
        const long L = (long)i * G + c; if (L >= nwg) return false;
        int wgid = (int)L; { const int q = nwg / NXCD, r = nwg % NXCD, xcd = wgid % NXCD, off = wgid / NXCD; wgid = (xcd < r ? xcd * (q + 1) : r * (q + 1) + (xcd - r) * q) + off; }
        const int nig = WGM * nN, gid = wgid / nig, fm = gid * WGM, gsz = (nM - fm) < WGM ? (nM - fm) : WGM;
        u.pm = fm + ((wgid % nig) % gsz); u.pn = (wgid % nig) / gsz; return true;
    }
    __device__ __forceinline__ void a_ready(const Unit&) const {}
    __device__ __forceinline__ void done(const Unit&) const {}
};

__device__ __forceinline__ unsigned cvt_pk_bf16(float lo, float hi) { unsigned r; asm volatile("v_cvt_pk_bf16_f32 %0, %1, %2" : "=v"(r) : "v"(lo), "v"(hi)); return r; }
typedef unsigned u32x2e __attribute__((ext_vector_type(2)));
__device__ __forceinline__ float silu_f(float a) { return a * __builtin_amdgcn_rcpf(1.0f + __expf(-a)); }
struct EpiZ {
    static constexpr bool PERM = true, AFTER_DRAIN = false;
    PG8_GAS bf16_t* O; int ldc; PG8_GAS float* kv; int e;
    __device__ __forceinline__ void operator()(const f32x4 (&acc)[2][2][4][2], const Unit& u, int wr, int wc, int fr, int fq) const {
        const int row0 = u.pm * BM + wr * 64 + fr, col0 = u.pn * BM + wc * 32 + 8 * fq;
        const bool do_kv = (kv != nullptr) && (u.pm < 32) && (u.pn >= 2) && (u.pn < 6);
#pragma unroll
        for (int ai = 0; ai < 2; ++ai)
#pragma unroll
            for (int m = 0; m < 4; ++m) { const int row = row0 + ai * HALF + m * 16; PG8_GAS bf16_t* rowp = O + (size_t)row * ldc + col0;
#pragma unroll
                for (int bj = 0; bj < 2; ++bj) { const f32x4 v0 = acc[ai][bj][m][0], v1 = acc[ai][bj][m][1];
                    u32x4 w; w.x = cvt_pk_bf16(v0[0], v0[1]); w.y = cvt_pk_bf16(v0[2], v0[3]); w.z = cvt_pk_bf16(v1[0], v1[1]); w.w = cvt_pk_bf16(v1[2], v1[3]);
                    *(PG8_GAS u32x4*)(rowp + bj * HALF) = w;
                    if (do_kv) { const int c = col0 + bj * HALF - 512, kvi = c >> 9, hh = (c & 511) >> 6, d = c & 63, b = row >> 8, t = row & 255;
                        PG8_GAS float* p = kv + ((((size_t)(b * 2 + e) * 2 + kvi) * 8 + hh) * 256 + t) * 64 + d;
                        *(PG8_GAS f32x4*)p = v0; *(PG8_GAS f32x4*)(p + 4) = v1; } } }
    }
};
struct EpiF32 {
    static constexpr bool PERM = false, AFTER_DRAIN = false;
    PG8_GAS float* O; int ldc;
    __device__ __forceinline__ void operator()(const f32x4 (&acc)[2][2][4][2], const Unit& u, int wr, int wc, int fr, int fq) const {
        const int row0 = u.pm * BM + wr * 64 + fr, col0 = u.pn * BM + wc * 32 + 4 * fq;
#pragma unroll
        for (int ai = 0; ai < 2; ++ai)
#pragma unroll
            for (int m = 0; m < 4; ++m) { PG8_GAS float* rowp = O + (size_t)(row0 + ai * HALF + m * 16) * ldc + col0;
#pragma unroll
                for (int bj = 0; bj < 2; ++bj)
#pragma unroll
                    for (int n = 0; n < 2; ++n) *(PG8_GAS f32x4*)(rowp + bj * HALF + n * 16) = acc[ai][bj][m][n]; }
    }
};
struct EpiSwiglu {
    static constexpr bool PERM = true, AFTER_DRAIN = false;
    PG8_GAS bf16_t* O; int ldc;
    __device__ __forceinline__ void operator()(const f32x4 (&acc)[2][2][4][2], const Unit& u, int wr, int wc, int fr, int fq) const {
        const int row0 = u.pm * BM + wr * 64 + fr, col0 = u.pn * HALF + wc * 32 + 8 * fq;
#pragma unroll
        for (int ai = 0; ai < 2; ++ai)
#pragma unroll
            for (int m = 0; m < 4; ++m) { PG8_GAS bf16_t* rowp = O + (size_t)(row0 + ai * HALF + m * 16) * ldc + col0;
                const f32x4 a0 = acc[ai][0][m][0], a1 = acc[ai][0][m][1], u0 = acc[ai][1][m][0], u1 = acc[ai][1][m][1];
                u32x4 w;
                w.x = cvt_pk_bf16(silu_f(a0[0]) * u0[0], silu_f(a0[1]) * u0[1]); w.y = cvt_pk_bf16(silu_f(a0[2]) * u0[2], silu_f(a0[3]) * u0[3]);
                w.z = cvt_pk_bf16(silu_f(a1[0]) * u1[0], silu_f(a1[1]) * u1[1]); w.w = cvt_pk_bf16(silu_f(a1[2]) * u1[2], silu_f(a1[3]) * u1[3]);
                *(PG8_GAS u32x4*)rowp = w; }
    }
};
template <class Epi, class Sched, bool ALIGN_EPI = false, bool SP2 = false>
__device__ __forceinline__ void gemm_phase(PG8_LAS unsigned char* lds, const Gemm g, const Sched& S, const Epi& E) {
    int tid_ = threadIdx.x; asm volatile("" : "+v"(tid_)); const int tid = tid_, wid = __builtin_amdgcn_readfirstlane(tid >> 6), lane = tid & 63, wr = wid >> 2, wc = wid & 3, fr = lane & 15, fq = lane >> 4;
    const int K = g.K, nt = K / BK;
    unsigned voffA[2], voffB[2];
#pragma unroll
    for (int i = 0; i < 2; ++i) { int R, C; stage_rc(tid * 16 + i * 8192, R, C); const int Rb = Epi::PERM ? ((R & ~31) + perm32(R & 31)) : R;
        voffA[i] = (unsigned)(R * K + C) * 2u; voffB[i] = (unsigned)(Rb * K + C) * 2u; }
    const size_t kstep = (size_t)(BK * 2);
    const size_t hstep = (size_t)HALF * K * 2;
    const size_t tstep = 2 * hstep;
    const unsigned ldsw = (unsigned)wid * 1024u;
    const int aoff = lds_byte(wr * 64 + fr, fq * 8), boff = lds_byte(wc * 32 + fr, fq * 8);
#define PG8_SA(b, h) (((b) * 2 + (h)) * HTB)
#define PG8_SB(b, h) ((4 + (b) * 2 + (h)) * HTB)
#define PG8_STAGE(bufoff, gbase, voff) do { _Pragma("unroll") for (int _i = 0; _i < 2; ++_i) \
        __builtin_amdgcn_global_load_lds((const PG8_GAS unsigned*)((const PG8_GAS char*)(gbase) + (voff)[_i]), (PG8_LAS unsigned*)(lds + (bufoff) + ldsw + _i * 8192), 16, 0, 0); } while (0)
#define PG8_LDA(dst, b, h) do { _Pragma("unroll") for (int m = 0; m < 4; ++m) _Pragma("unroll") for (int k = 0; k < 2; ++k) dst[m][k] = *(const PG8_LAS bf16x8*)(lds + PG8_SA(b, h) + aoff + m * 2048 + k * 1024); } while (0)
#define PG8_LDB(dst, b, h) do { _Pragma("unroll") for (int n = 0; n < 2; ++n) _Pragma("unroll") for (int k = 0; k < 2; ++k) dst[n][k] = *(const PG8_LAS bf16x8*)(lds + PG8_SB(b, h) + boff + n * 2048 + k * 1024); } while (0)
#define PG8_MMA(ai, bj, At, Bt) do { __builtin_amdgcn_s_setprio(1); _Pragma("unroll") for (int m = 0; m < 4; ++m) _Pragma("unroll") for (int n = 0; n < 2; ++n) _Pragma("unroll") for (int k = 0; k < 2; ++k) \
        acc[ai][bj][m][n] = __builtin_amdgcn_mfma_f32_16x16x32_bf16(Bt[n][k], At[m][k], acc[ai][bj][m][n], 0, 0, 0); __builtin_amdgcn_s_setprio(0); } while (0)
#define PG8_WAIT_V(n) asm volatile("s_waitcnt vmcnt(" #n ")" ::: "memory")
#define PG8_WAIT_L(n) asm volatile("s_waitcnt lgkmcnt(" #n ")" ::: "memory")
#define PG8_BAR __builtin_amdgcn_s_barrier()
#define PG8_SCHED __builtin_amdgcn_sched_barrier(0)
    Unit cur, nxt; int ui = 0;
    if (!S.next(0, cur)) return;
    f32x4 acc[2][2][4][2];
#pragma unroll
    for (int a = 0; a < 2; ++a)
#pragma unroll
        for (int b = 0; b < 2; ++b)
#pragma unroll
            for (int m = 0; m < 4; ++m)
#pragma unroll
                for (int n = 0; n < 2; ++n) acc[a][b][m][n] = (f32x4){0.f, 0.f, 0.f, 0.f};
    bf16x8 At[4][2], B0[2][2], B1[2][2];
    const PG8_GAS char* cA = (const PG8_GAS char*)g.A + (size_t)cur.pm * tstep; const PG8_GAS char* cB = (const PG8_GAS char*)g.Bt + (size_t)cur.pn * tstep;
    S.a_ready(cur);
    if constexpr (SP2) {
        PG8_STAGE(PG8_SB(0, 0), cB, voffB); PG8_STAGE(PG8_SB(0, 1), cB + hstep, voffB); PG8_STAGE(PG8_SA(0, 0), cA, voffA); PG8_STAGE(PG8_SA(0, 1), cA + hstep, voffA);
        if (wr == 1) PG8_BAR;
        PG8_WAIT_V(2); PG8_BAR;
        PG8_STAGE(PG8_SB(1, 0), cB + kstep, voffB); PG8_STAGE(PG8_SA(1, 0), cA + kstep, voffA); PG8_STAGE(PG8_SB(1, 1), cB + hstep + kstep, voffB);
        PG8_WAIT_V(6); PG8_BAR;
    } else {
        PG8_STAGE(PG8_SB(0, 0), cB, voffB); PG8_STAGE(PG8_SA(0, 0), cA, voffA); PG8_STAGE(PG8_SB(0, 1), cB + hstep, voffB); PG8_STAGE(PG8_SA(0, 1), cA + hstep, voffA);
        if (wr == 1) PG8_BAR;
        PG8_WAIT_V(4); PG8_BAR;
        PG8_STAGE(PG8_SB(1, 0), cB + kstep, voffB); PG8_STAGE(PG8_SA(1, 0), cA + kstep, voffA); PG8_STAGE(PG8_SB(1, 1), cB + hstep + kstep, voffB);
        PG8_WAIT_V(6); PG8_BAR;
    }
    for (;;) {
        const bool has_next = S.next(ui + 1, nxt);
        const PG8_GAS char* nA = has_next ? (const PG8_GAS char*)g.A + (size_t)nxt.pm * tstep : cA; const PG8_GAS char* nB = has_next ? (const PG8_GAS char*)g.Bt + (size_t)nxt.pn * tstep : cB;
        for (int t = 0; t < nt; t += 2) {
            const bool last = (t == nt - 2);
            const PG8_GAS char* a1 = cA + (size_t)(t + 1) * kstep;
            const PG8_GAS char* a2 = last ? nA : cA + (size_t)(t + 2) * kstep; const PG8_GAS char* b2 = last ? nB : cB + (size_t)(t + 2) * kstep;
            const PG8_GAS char* a3 = a2 + kstep; const PG8_GAS char* b3 = b2 + kstep;
            if (last && has_next) S.a_ready(nxt);
            if constexpr (SP2) {
            PG8_LDB(B0, 0, 0); PG8_LDB(B1, 0, 1); PG8_SCHED; PG8_LDA(At, 0, 0); PG8_STAGE(PG8_SA(1, 1), a1 + hstep, voffA);
            PG8_WAIT_V(8); PG8_WAIT_L(0); PG8_BAR; PG8_MMA(0, 0, At, B0); PG8_MMA(0, 1, At, B1); PG8_BAR; PG8_SCHED;
            PG8_LDA(At, 0, 1); PG8_STAGE(PG8_SB(0, 0), b2, voffB); PG8_STAGE(PG8_SB(0, 1), b2 + hstep, voffB); PG8_STAGE(PG8_SA(0, 0), a2, voffA);
            PG8_WAIT_V(8); PG8_WAIT_L(0); PG8_BAR; PG8_MMA(1, 0, At, B0); PG8_MMA(1, 1, At, B1); PG8_BAR; PG8_SCHED;
            PG8_LDB(B0, 1, 0); PG8_LDB(B1, 1, 1); PG8_SCHED; PG8_LDA(At, 1, 0); PG8_STAGE(PG8_SA(0, 1), a2 + hstep, voffA);
            PG8_WAIT_V(8); PG8_WAIT_L(0); PG8_BAR; PG8_MMA(0, 0, At, B0); PG8_MMA(0, 1, At, B1); PG8_BAR; PG8_SCHED;
            PG8_LDA(At, 1, 1); PG8_STAGE(PG8_SB(1, 0), b3, voffB); PG8_STAGE(PG8_SB(1, 1), b3 + hstep, voffB); PG8_STAGE(PG8_SA(1, 0), a3, voffA);
            PG8_WAIT_V(8); PG8_WAIT_L(0); PG8_BAR; PG8_MMA(1, 0, At, B0); PG8_MMA(1, 1, At, B1); PG8_BAR; PG8_SCHED;
            } else {
            PG8_LDB(B0, 0, 0); PG8_SCHED; PG8_LDA(At, 0, 0); PG8_STAGE(PG8_SA(1, 1), a1 + hstep, voffA);
            PG8_WAIT_L(8); PG8_BAR; PG8_WAIT_L(0); PG8_MMA(0, 0, At, B0); PG8_BAR; PG8_SCHED;
            PG8_LDB(B1, 0, 1); PG8_STAGE(PG8_SB(0, 0), b2, voffB);
            PG8_BAR; PG8_WAIT_L(0); PG8_MMA(0, 1, At, B1); PG8_BAR;
            PG8_LDA(At, 0, 1); PG8_STAGE(PG8_SA(0, 0), a2, voffA);
            PG8_BAR; PG8_WAIT_L(0); PG8_MMA(1, 0, At, B0); PG8_BAR; PG8_SCHED;
            PG8_STAGE(PG8_SB(0, 1), b2 + hstep, voffB);
            PG8_WAIT_V(6); PG8_BAR; PG8_MMA(1, 1, At, B1); PG8_BAR;
            PG8_LDB(B0, 1, 0); PG8_SCHED; PG8_LDA(At, 1, 0); PG8_STAGE(PG8_SA(0, 1), a2 + hstep, voffA);
            PG8_WAIT_L(8); PG8_BAR; PG8_WAIT_L(0); PG8_MMA(0, 0, At, B0); PG8_BAR; PG8_SCHED;
            PG8_LDB(B1, 1, 1); PG8_STAGE(PG8_SB(1, 0), b3, voffB);
            PG8_BAR; PG8_WAIT_L(0); PG8_MMA(0, 1, At, B1); PG8_BAR;
            PG8_LDA(At, 1, 1); PG8_STAGE(PG8_SA(1, 0), a3, voffA);
            PG8_BAR; PG8_WAIT_L(0); PG8_MMA(1, 0, At, B0); PG8_BAR; PG8_SCHED;
            PG8_STAGE(PG8_SB(1, 1), b3 + hstep, voffB);
            PG8_WAIT_V(6); PG8_BAR; PG8_MMA(1, 1, At, B1); PG8_BAR;
            }
        }
        if constexpr (ALIGN_EPI) { if (wr == 0) PG8_BAR; }
        if constexpr (!Epi::AFTER_DRAIN) { E(acc, cur, wr, wc, fr, fq); S.done(cur); }
        if (!has_next) break;
#pragma unroll
        for (int a = 0; a < 2; ++a)
#pragma unroll
            for (int b = 0; b < 2; ++b)
#pragma unroll
                for (int m = 0; m < 4; ++m)
#pragma unroll
                    for (int n = 0; n < 2; ++n) acc[a][b][m][n] = (f32x4){0.f, 0.f, 0.f, 0.f};
        cur = nxt; cA = nA; cB = nB; ++ui;
        if constexpr (ALIGN_EPI) { if (wr == 1) PG8_BAR; }
    }
    PG8_WAIT_V(0);
    if constexpr (!ALIGN_EPI) { if (wr == 0) PG8_BAR; }
    PG8_BAR;
    if constexpr (Epi::AFTER_DRAIN) { E.fused(acc, cur, wr, wc, fr, fq, lds, wid, lane); S.done(cur); }
#undef PG8_SA
#undef PG8_SB
#undef PG8_STAGE
#undef PG8_LDA
#undef PG8_LDB
#undef PG8_MMA
#undef PG8_WAIT_V
#undef PG8_WAIT_L
#undef PG8_BAR
#undef PG8_SCHED
}
}
#define GAS __attribute__((address_space(1)))
#define LAS __attribute__((address_space(3)))
typedef unsigned short bf16;
typedef unsigned v4u __attribute__((ext_vector_type(4)));
typedef float f32x4 __attribute__((ext_vector_type(4)));
typedef short bf16x8 __attribute__((ext_vector_type(8)));
typedef GAS unsigned gu32;
typedef GAS unsigned long long gu64;
#define RLX_AGENT __ATOMIC_RELAXED, __HIP_MEMORY_SCOPE_AGENT
#define LDS_WAIT() asm volatile("s_waitcnt lgkmcnt(0)" ::: "memory")
#define VM_WAIT() asm volatile("s_waitcnt vmcnt(0)" ::: "memory")
__device__ __forceinline__ unsigned long long rt() { return __builtin_amdgcn_s_memrealtime(); }
__device__ __forceinline__ unsigned f2bf(float f) { unsigned u = __builtin_bit_cast(unsigned, f); return (u + 0x7fffu + ((u >> 16) & 1u)) >> 16; }
__device__ __forceinline__ unsigned pk2(float lo, float hi) { return f2bf(lo) | (f2bf(hi) << 16); }
#define XB_TMO      128
#define XB_XCNT(j)  (256  + 64 * (j))
#define XB_XSUB(j)  (1280 + 64 * (j))
#define XB_XGEN(j)  (2304 + 64 * (j))
#define XB_TOP      3328
#define XB_TOPGEN   3392
#define XCD_BAR_WORDS 3456
#define XB_SPIN_CAP (1u << 18)

__device__ __forceinline__ unsigned xb_ld(unsigned* p)              { return __hip_atomic_load(p, __ATOMIC_RELAXED, __HIP_MEMORY_SCOPE_AGENT); }
__device__ __forceinline__ unsigned xb_add(unsigned* p, unsigned v) { return __hip_atomic_fetch_add(p, v, __ATOMIC_RELAXED, __HIP_MEMORY_SCOPE_AGENT); }
__device__ __forceinline__ unsigned xb_xcc_id() { return (unsigned)__builtin_amdgcn_s_getreg((3 << 11) | 20) & 0xFu; }
#define XB_SPIN(cond, bar) do { unsigned _sp = 0; while (cond) { __builtin_amdgcn_s_sleep(1); \
    if ((++_sp & 255u) == 0u) { if (xb_ld(&(bar)[XB_TMO])) break; if (_sp > XB_SPIN_CAP) { atomicAdd(&(bar)[XB_TMO], 1u); break; } } } } while (0)

struct XcdBarrier {
    unsigned* bar; unsigned x;
    volatile LAS unsigned* st;
};

__device__ __forceinline__ XcdBarrier xcd_barrier_post(unsigned* bar, volatile LAS unsigned* st) {
    XcdBarrier b; b.bar = bar; b.x = xb_xcc_id(); b.st = st;
    if (threadIdx.x == 0) (void)xb_add(&bar[XB_XCNT(b.x)], 1u);
    return b;
}
__device__ __forceinline__ void xcd_barrier_complete(unsigned* bar, unsigned x, unsigned& nloc, unsigned& nx) {
    const unsigned G = gridDim.x * gridDim.y * gridDim.z;
    unsigned sum, cnt, mine, sp = 0u;
    for (;;) {
        sum = 0u; cnt = 0u; mine = 0u;
#pragma unroll
        for (unsigned j = 0; j < 16; ++j) { const unsigned c = xb_ld(&bar[XB_XCNT(j)]); sum += c; cnt += (c > 0u) ? 1u : 0u; mine = (j == x) ? c : mine; }
        if (sum == G) break;
        __builtin_amdgcn_s_sleep(1);
        if ((++sp & 255u) == 0u) { if (xb_ld(&bar[XB_TMO])) break; if (sp > XB_SPIN_CAP) { atomicAdd(&bar[XB_TMO], 1u); break; } }
    }
    nloc = mine > 0u ? mine : 1u; nx = cnt > 0u ? cnt : 1u;
}

__device__ __forceinline__ void xcd_barrier(const XcdBarrier& b) {
    asm volatile("s_waitcnt vmcnt(0)" ::: "memory");
    __syncthreads();
    if (threadIdx.x == 0) {
        unsigned* bar = b.bar;
        __builtin_amdgcn_s_waitcnt(0);
        unsigned nloc = b.st[0], nx = b.st[1];
        if (nloc == 0u) { xcd_barrier_complete(bar, b.x, nloc, nx); b.st[0] = nloc; b.st[1] = nx; }
        const unsigned old = xb_add(&bar[XB_XSUB(b.x)], 1u);
        const unsigned gen = old / nloc;
        if (old + 1u == (gen + 1u) * nloc) {
            __builtin_amdgcn_fence(__ATOMIC_RELEASE, "agent");
            asm volatile("s_waitcnt vmcnt(0)" ::: "memory");
            const unsigned og = xb_add(&bar[XB_TOP], 1u);
            const unsigned tg = og / nx;
            if (og + 1u == (tg + 1u) * nx) xb_add(&bar[XB_TOPGEN], 1u);
            else XB_SPIN(xb_ld(&bar[XB_TOPGEN]) == tg, bar);
            __builtin_amdgcn_fence(__ATOMIC_ACQUIRE, "agent");
            xb_add(&bar[XB_XGEN(b.x)], 1u);
            asm volatile("s_waitcnt vmcnt(0)" ::: "memory");
        } else {
            XB_SPIN(xb_ld(&bar[XB_XGEN(b.x)]) == gen, bar);
            __builtin_amdgcn_fence(__ATOMIC_ACQUIRE, "agent");
            asm volatile("s_waitcnt vmcnt(0)" ::: "memory");
        }
    }
    __syncthreads();
}
constexpr int NWAVES = 8, NTHREADS = 512;
constexpr int DM = 1024, MROWS = 16384, MP = 8192;
constexpr int NE_IN = 3584, NO_IN = 5120, DFF = 2816, NFF_IN = 5632;
constexpr float EPS_N = 1e-6f;
constexpr size_t OUT_KV = 16777216, OUT_SR = 33554432, OUT_SH = 37748736;
constexpr size_t MiB = 1u << 20;
constexpr size_t WS_CTL = 0, WS_MOD = 1 * MiB, CTL_ZERO_BYTES = 2 * MiB;
constexpr size_t WS_LOWER = 2 * MiB;
constexpr size_t WS_WTE_IN = 3 * MiB, WS_WTE_OUT = 17 * MiB, WS_WTO_IN = 21 * MiB, WS_WTO_OUT = 41 * MiB, WS_WTF_IN = 45 * MiB, WS_WTF_OUT = 89 * MiB;
constexpr size_t WS_H = 111 * MiB;
constexpr size_t WS_Z = 143 * MiB;
constexpr size_t WS_M = 303 * MiB;
constexpr size_t WS_END = 367 * MiB;
constexpr int CW_BAR = 4096;

constexpr int RING_BYTES = 131072, LDSCTL_OFF = RING_BYTES, MISC_OFF = LDSCTL_OFF + 320, LDS_BYTES = 147456;

__device__ __forceinline__ float bf2f(unsigned short b) { return __uint_as_float((unsigned)b << 16); }
__device__ __forceinline__ void unpack8(const v4u w, float (&f)[8]) {
    f[0] = __uint_as_float(w.x << 16); f[1] = __uint_as_float(w.x & 0xffff0000u); f[2] = __uint_as_float(w.y << 16); f[3] = __uint_as_float(w.y & 0xffff0000u);
    f[4] = __uint_as_float(w.z << 16); f[5] = __uint_as_float(w.z & 0xffff0000u); f[6] = __uint_as_float(w.w << 16); f[7] = __uint_as_float(w.w & 0xffff0000u);
}
__device__ __forceinline__ unsigned short f2bf16(float f) { return (unsigned short)f2bf(f); }
__device__ __forceinline__ float wave_sum(float v) {
#pragma unroll
    for (int o = 1; o < 64; o <<= 1) v += __shfl_xor(v, o);
    return v;
}
__device__ __forceinline__ float sigmoid_f(float x) { return 1.0f / (1.0f + __expf(-x)); }

struct Args { const float* in[20]; float* out; unsigned char* ws; int ph_lo, ph_hi; };
struct Ctx {
    LAS unsigned char* lds;
    __device__ __forceinline__ unsigned long long rd(int i) const { volatile LAS unsigned long long* t = (volatile LAS unsigned long long*)(lds + LDSCTL_OFF); const unsigned long long v = t[i];
        const unsigned lo = __builtin_amdgcn_readfirstlane((unsigned)v), hi = __builtin_amdgcn_readfirstlane((unsigned)(v >> 32)); return ((unsigned long long)hi << 32) | lo; }
    __device__ __forceinline__ const GAS float* in(int i) const { return (const GAS float*)rd(i); }
    __device__ __forceinline__ GAS float* out() const { return (GAS float*)rd(20); }
    __device__ __forceinline__ GAS unsigned char* ws() const { return (GAS unsigned char*)rd(21); }
};

template <bool FFN>
__device__ __forceinline__ void transpose_item(const GAS float* W, int K, int N, GAS bf16* WT, LAS float* scr, int item, int lane) {
    const int nblk = N / 32, kb = item / nblk, nb = item % nblk, k0 = 64 * kb, n0d = 32 * nb;
    int n0s = n0d;
    if (FFN) { const int tile = n0d >> 8, within = n0d & 255; n0s = (within < 128) ? tile * 128 + within : DFF + tile * 128 + (within - 128); }
#pragma unroll 8
    for (int i = 0; i < 32; ++i) { const int kk = 2 * i + (lane >> 5); scr[kk * 33 + (lane & 31)] = W[(size_t)(k0 + kk) * N + n0s + (lane & 31)]; }
    LDS_WAIT(); asm volatile("" ::: "memory");
    const int c = lane & 7;
#pragma unroll
    for (int j = 0; j < 4; ++j) { const int n = (lane >> 3) + 8 * j; const LAS float* s = scr + (8 * c) * 33 + n;
        v4u o; o.x = pk2(s[0 * 33], s[1 * 33]); o.y = pk2(s[2 * 33], s[3 * 33]); o.z = pk2(s[4 * 33], s[5 * 33]); o.w = pk2(s[6 * 33], s[7 * 33]);
        *(GAS v4u*)(WT + (size_t)(n0d + n) * K + k0 + 8 * c) = o; }
    LDS_WAIT(); asm volatile("" ::: "memory");
}

__device__ __forceinline__ void phase_p0(const Ctx& a, LAS unsigned char* lds, int tid, int lane, int wave, int bid, int G) {
    LAS float* sc = (LAS float*)lds;
    { const GAS float* cctx = a.in(6); const GAS float* cc = a.in(5);
      for (int i = tid; i < 9 * 1024; i += NTHREADS) { const int r = i >> 10, k = i & 1023; const float v = (r == 0) ? cctx[k] : cc[(r - 1) * 1024 + k]; sc[i] = v * sigmoid_f(v); } }
    __syncthreads();
    LAS float* red = (LAS float*)(lds + 40960);
    GAS float* MOD = (GAS float*)(a.ws() + WS_MOD); const GAS float* wm = a.in(7); const GAS float* bm = a.in(8);
    for (int u = bid; u < 384; u += G) {
        const int l = u / 96, nb = u % 96;
        const int col = tid & 63, ks = tid >> 6, n = nb * 64 + col, k0 = ks * 128;
        const GAS float* w = wm + ((size_t)l * 1024 + k0) * 6144 + n;
        float acc[9];
#pragma unroll
        for (int r = 0; r < 9; ++r) acc[r] = 0.f;
#pragma unroll 4
        for (int k = 0; k < 128; ++k) { const float wv = w[(size_t)k * 6144];
#pragma unroll
            for (int r = 0; r < 9; ++r) acc[r] += sc[r * 1024 + k0 + k] * wv; }
#pragma unroll
        for (int r = 0; r < 9; ++r) red[(ks * 64 + col) * 9 + r] = acc[r];
        __syncthreads();
        for (int o = tid; o < 576; o += NTHREADS) { const int c = o / 9, r = o % 9; float sum = bm[l * 6144 + nb * 64 + c];
#pragma unroll
            for (int q = 0; q < 8; ++q) sum += red[(q * 64 + c) * 9 + r];
            MOD[((size_t)l * 9 + r) * 6144 + nb * 64 + c] = sum; }
        __syncthreads();
    }
    { GAS float* LOWER = (GAS float*)(a.ws() + WS_LOWER); const GAS float* hlb = a.in(16);
      for (int idx = bid * NTHREADS + tid; idx < 2048; idx += G * NTHREADS) {
          const float x0 = hlb[idx], x1 = hlb[2048 + idx], mx = fmaxf(x0, x1), e0 = expf(x0 - mx), e1 = expf(x1 - mx), s = e0 + e1, p0 = e0 / s, p1 = e1 / s;
          LOWER[idx] = fminf(fmaxf(p0 - p0, 0.f), 1.f); LOWER[2048 + idx] = fminf(fmaxf((p0 + p1) - p0, 0.f), 1.f); } }
    __syncthreads();
    LAS float* scr = (LAS float*)(lds + wave * 16384);
    const int gw = bid * NWAVES + wave, NGW = G * NWAVES;
    for (int it = gw; it < 27648; it += NGW) {
        int r = it;
        if (r < 3584) { const int e = r / 1792; transpose_item<false>(a.in(10) + (size_t)e * 1024 * NE_IN, 1024, NE_IN, (GAS bf16*)(a.ws() + WS_WTE_IN) + (size_t)e * NE_IN * 1024, scr, r % 1792, lane); continue; } r -= 3584;
        if (r < 1024) { const int e = r / 512; transpose_item<false>(a.in(11) + (size_t)e * 1048576, 1024, 1024, (GAS bf16*)(a.ws() + WS_WTE_OUT) + (size_t)e * 1048576, scr, r % 512, lane); continue; } r -= 1024;
        if (r < 5120) { const int o = r / 2560; transpose_item<false>(a.in(14) + (size_t)o * 1024 * NO_IN, 1024, NO_IN, (GAS bf16*)(a.ws() + WS_WTO_IN) + (size_t)o * NO_IN * 1024, scr, r % 2560, lane); continue; } r -= 5120;
        if (r < 1024) { const int o = r / 512; transpose_item<false>(a.in(15) + (size_t)o * 1048576, 1024, 1024, (GAS bf16*)(a.ws() + WS_WTO_OUT) + (size_t)o * 1048576, scr, r % 512, lane); continue; } r -= 1024;
        if (r < 11264) { const int l = r / 2816; transpose_item<true>(a.in(18) + (size_t)l * 1024 * NFF_IN, 1024, NFF_IN, (GAS bf16*)(a.ws() + WS_WTF_IN) + (size_t)l * NFF_IN * 1024, scr, r % 2816, lane); continue; } r -= 11264;
        { const int l = r / 1408; transpose_item<false>(a.in(19) + (size_t)l * DFF * 1024, DFF, 1024, (GAS bf16*)(a.ws() + WS_WTF_OUT) + (size_t)l * 1024 * DFF, scr, r % 1408, lane); }
    }
}

__device__ __forceinline__ void phase_rowpass(const Ctx& a, int l, int mode, int lane, int gw, int NGW) {
    GAS float* X = a.out(); const GAS float* Mb = (const GAS float*)(a.ws() + WS_M); GAS bf16* H = (GAS bf16*)(a.ws() + WS_H); const GAS float* MOD = (const GAS float*)(a.ws() + WS_MOD); const GAS float* ng = a.in(9); const GAS float* xin0 = a.in(0); const GAS float* xin1 = a.in(1);
    const GAS float* g_a = ng + (size_t)(l * 4 + (mode == 1 ? 1 : 3)) * 1024;
    const int gt_off = (mode == 1) ? 2048 : 5120;
    const int lh = (mode == 2) ? l + 1 : l;
    const bool doH = !(mode == 2 && l == 3);
    const GAS float* g_b = ng + (size_t)((doH ? lh : 0) * 4 + (mode == 1 ? 2 : 0)) * 1024;
    const int sh_off = (mode == 1) ? 3072 : 0, sc_off = (mode == 1) ? 4096 : 1024;
    for (int row = gw; row < MROWS; row += NGW) {
        const int bidx = row < MP ? 0 : 1 + ((row - MP) >> 10);
        const GAS float* modl = MOD + ((size_t)l * 9 + bidx) * 6144;
        const GAS float* modh = MOD + ((size_t)(doH ? lh : 0) * 9 + bidx) * 6144;
        const GAS float* xsrc = (mode == 0) ? (row < MP ? xin0 + (size_t)row * 1024 : xin1 + (size_t)(row - MP) * 1024) : X + (size_t)row * 1024;
        f32x4 xv[4];
#pragma unroll
        for (int j = 0; j < 4; ++j) xv[j] = *(const GAS f32x4*)(xsrc + lane * 4 + 256 * j);
        if (mode != 0) {
            f32x4 mv[4]; float ss = 0.f;
#pragma unroll
            for (int j = 0; j < 4; ++j) { mv[j] = *(const GAS f32x4*)(Mb + (size_t)row * 1024 + lane * 4 + 256 * j); ss += (mv[j].x * mv[j].x + mv[j].y * mv[j].y) + (mv[j].z * mv[j].z + mv[j].w * mv[j].w); }
            const float rstd = rsqrtf(wave_sum(ss) * (1.f / 1024.f) + EPS_N);
#pragma unroll
            for (int j = 0; j < 4; ++j) { const f32x4 ga = *(const GAS f32x4*)(g_a + lane * 4 + 256 * j), gt = *(const GAS f32x4*)(modl + gt_off + lane * 4 + 256 * j);
                xv[j] = xv[j] + gt * (mv[j] * rstd * ga); }
        }
#pragma unroll
        for (int j = 0; j < 4; ++j) *(GAS f32x4*)(X + (size_t)row * 1024 + lane * 4 + 256 * j) = xv[j];
        if (doH) {
            float ss = 0.f;
#pragma unroll
            for (int j = 0; j < 4; ++j) ss += (xv[j].x * xv[j].x + xv[j].y * xv[j].y) + (xv[j].z * xv[j].z + xv[j].w * xv[j].w);
            const float rstd = rsqrtf(wave_sum(ss) * (1.f / 1024.f) + EPS_N);
#pragma unroll
            for (int j = 0; j < 4; ++j) { const f32x4 gb = *(const GAS f32x4*)(g_b + lane * 4 + 256 * j), sc = *(const GAS f32x4*)(modh + sc_off + lane * 4 + 256 * j), sh = *(const GAS f32x4*)(modh + sh_off + lane * 4 + 256 * j);
                const f32x4 hv = xv[j] * rstd * gb * (sc + 1.0f) + sh;
                *(GAS unsigned long long*)(H + (size_t)row * 1024 + lane * 4 + 256 * j) = (unsigned long long)pk2(hv.x, hv.y) | ((unsigned long long)pk2(hv.z, hv.w) << 32); }
        }
    }
}

struct SoftAcc { float m, l; float o[64]; };
__device__ __forceinline__ void soft_init(SoftAcc& s) { s.m = -INFINITY; s.l = 0.f;
#pragma unroll
    for (int d = 0; d < 64; ++d) s.o[d] = 0.f; }
#define CFENCE() asm volatile("" ::: "memory")
struct RowLds  { const LAS float* p; __device__ __forceinline__ f32x4 operator()(int c) const { return *(const LAS f32x4*)(p + 4 * c); } };
struct RowGf32 { const GAS float* p;     __device__ __forceinline__ f32x4 operator()(int c) const { return *(const GAS f32x4*)(p + 4 * c); } };
struct RowGbf  { const GAS bf16* p;      __device__ __forceinline__ f32x4 operator()(int c) const { const unsigned long long w = *(const GAS unsigned long long*)(p + 4 * c); const unsigned lo = (unsigned)w, hi = (unsigned)(w >> 32);
    return (f32x4){__uint_as_float(lo << 16), __uint_as_float(lo & 0xffff0000u), __uint_as_float(hi << 16), __uint_as_float(hi & 0xffff0000u)}; } };
template <class R> __device__ __forceinline__ float dot64(const float (&q)[64], const R& r, float init) {
    float sc = init;
#pragma unroll
    for (int c = 0; c < 16; ++c) { const f32x4 k = r(c); sc += q[4 * c] * k.x; sc += q[4 * c + 1] * k.y; sc += q[4 * c + 2] * k.z; sc += q[4 * c + 3] * k.w; if ((c & 3) == 3) CFENCE(); }
    return sc;
}
template <class R> __device__ __forceinline__ void soft_upd(SoftAcc& s, float sc, const R& r) {
    const float mn = fmaxf(s.m, sc), al = __expf(s.m - mn), p = __expf(sc - mn);
    s.l = s.l * al + p; s.m = mn;
#pragma unroll
    for (int c = 0; c < 16; ++c) { const f32x4 v = r(c); s.o[4 * c] = s.o[4 * c] * al + p * v.x; s.o[4 * c + 1] = s.o[4 * c + 1] * al + p * v.y; s.o[4 * c + 2] = s.o[4 * c + 2] * al + p * v.z; s.o[4 * c + 3] = s.o[4 * c + 3] * al + p * v.w; if ((c & 3) == 3) CFENCE(); }
}
__device__ __forceinline__ void soft_store(const SoftAcc& s, LAS float* p) { p[0] = s.m; p[1] = s.l;
#pragma unroll
    for (int d = 0; d < 64; ++d) p[2 + d] = s.o[d]; }
__device__ __forceinline__ void soft_merge(SoftAcc& s, const LAS float* p) {
    const float m2 = p[0], l2 = p[1], mn = fmaxf(s.m, m2), a1 = __expf(s.m - mn), a2 = __expf(m2 - mn);
    s.l = s.l * a1 + l2 * a2; s.m = mn;
#pragma unroll
    for (int d = 0; d < 64; ++d) s.o[d] = s.o[d] * a1 + p[2 + d] * a2;
}
__device__ __forceinline__ void load_row64_bf16(const GAS bf16* p, float (&f)[64]) {
#pragma unroll
    for (int c = 0; c < 8; ++c) { const v4u w = *(const GAS v4u*)(p + 8 * c); float t[8]; unpack8(w, t);
#pragma unroll
        for (int i = 0; i < 8; ++i) f[8 * c + i] = t[i]; }
}
__device__ __forceinline__ void store_row64_bf16(GAS bf16* p, const float (&f)[64], float scale) {
#pragma unroll
    for (int c = 0; c < 8; ++c) { v4u w; w.x = pk2(f[8 * c] * scale, f[8 * c + 1] * scale); w.y = pk2(f[8 * c + 2] * scale, f[8 * c + 3] * scale); w.z = pk2(f[8 * c + 4] * scale, f[8 * c + 5] * scale); w.w = pk2(f[8 * c + 6] * scale, f[8 * c + 7] * scale);
        *(GAS v4u*)(p + 8 * c) = w; }
}

__device__ __forceinline__ void ctx_attn_unit(const Ctx& a, LAS unsigned char* lds, int tid, int b, int h) {
    const GAS bf16* Z = (const GAS bf16*)(a.ws() + WS_Z); GAS bf16* O = (GAS bf16*)(a.ws() + WS_H);
    LAS float* sK = (LAS float*)lds; LAS float* sV = sK + 256 * 64;
    const size_t rb = (size_t)b * 256;
    for (int t = 0; t < 4; ++t) { const int idx = tid + NTHREADS * t, key = idx >> 3, ch = idx & 7; const GAS bf16* zr = Z + (rb + key) * NE_IN + h * 64 + ch * 8;
        float f[8]; unpack8(*(const GAS v4u*)(zr + 512), f);
        *(LAS f32x4*)(sK + key * 64 + ch * 8) = (f32x4){f[0], f[1], f[2], f[3]}; *(LAS f32x4*)(sK + key * 64 + ch * 8 + 4) = (f32x4){f[4], f[5], f[6], f[7]};
        unpack8(*(const GAS v4u*)(zr + 1024), f);
        *(LAS f32x4*)(sV + key * 64 + ch * 8) = (f32x4){f[0], f[1], f[2], f[3]}; *(LAS f32x4*)(sV + key * 64 + ch * 8 + 4) = (f32x4){f[4], f[5], f[6], f[7]}; }
    __syncthreads();
    const int q = tid & 255, half = tid >> 8;
    float qv[64]; load_row64_bf16(Z + (rb + q) * NE_IN + h * 64, qv);
#pragma unroll
    for (int d = 0; d < 64; ++d) qv[d] *= 0.125f;
    SoftAcc s; soft_init(s);
    for (int j = 0; j < 128; ++j) { const int key = half * 128 + j;
        const float sc = dot64(qv, RowLds{sK + key * 64}, 0.f);
        soft_upd(s, sc, RowLds{sV + key * 64}); }
    __syncthreads();
    LAS float* slot = (LAS float*)lds + q * 66;
    if (half == 1) soft_store(s, slot);
    __syncthreads();
    if (half == 0) { soft_merge(s, slot); store_row64_bf16(O + (rb + q) * 1024 + h * 64, s.o, 1.0f / s.l); }
    __syncthreads();
}

__device__ __forceinline__ void na_unit(const Ctx& a, LAS unsigned char* lds, int tid, int e, int b, int h, int r) {
    const GAS bf16* Z = (const GAS bf16*)(a.ws() + WS_Z); GAS bf16* O = (GAS bf16*)(a.ws() + WS_H);
    const int qc = tid & 63, p = tid >> 6;
    const size_t lb = (size_t)MP + (size_t)b * 1024;
    const int kr0 = min(max(r - 4, 0), 8), kr = kr0 + p, win0 = min(max(qc - 8, 0), 48);
    float qv[64]; load_row64_bf16(Z + (lb + r * 64 + qc) * NE_IN + h * 64, qv);
#pragma unroll
    for (int d = 0; d < 64; ++d) qv[d] *= 0.125f;
    const GAS float* rp = a.in(12) + ((size_t)(e * 8 + h) * 15 + (kr - r + 7)) * 31;
    SoftAcc s; soft_init(s);
    for (int j = 0; j < 16; ++j) { const int kc = win0 + j; const GAS bf16* zr = Z + (lb + kr * 64 + kc) * NE_IN + h * 64;
        const float sc = dot64(qv, RowGbf{zr + 512}, rp[kc - qc + 15]);
        soft_upd(s, sc, RowGbf{zr + 1024}); }
    const GAS float* ck = a.in(2) + ((((size_t)(b * 2 + e) * 2 + 0) * 8 + h) * 256) * 64;
    const GAS float* cv = a.in(2) + ((((size_t)(b * 2 + e) * 2 + 1) * 8 + h) * 256) * 64;
    for (int j = 0; j < 32; ++j) { const int kj = 32 * p + j;
        const float sc = dot64(qv, RowGf32{ck + (size_t)kj * 64}, 0.f);
        soft_upd(s, sc, RowGf32{cv + (size_t)kj * 64}); }
    LAS float* slots = (LAS float*)lds;
    if (p >= 4) soft_store(s, slots + ((p - 4) * 64 + qc) * 66);
    __syncthreads();
    if (p < 4) soft_merge(s, slots + (p * 64 + qc) * 66);
    __syncthreads();
    if (p == 2 || p == 3) soft_store(s, slots + ((p - 2) * 64 + qc) * 66);
    __syncthreads();
    if (p < 2) soft_merge(s, slots + (p * 64 + qc) * 66);
    __syncthreads();
    if (p == 1) soft_store(s, slots + qc * 66);
    __syncthreads();
    if (p == 0) { soft_merge(s, slots + qc * 66); store_row64_bf16(O + (lb + r * 64 + qc) * 1024 + h * 64, s.o, 1.0f / s.l); }
    __syncthreads();
}

__device__ __forceinline__ void ret_chain(const Ctx& a, LAS unsigned char* lds, int tid, int e, bool lat, int b, int h, int dir) {
    const GAS bf16* Z = (const GAS bf16*)(a.ws() + WS_Z); GAS bf16* OFB = (GAS bf16*)(a.ws() + WS_M + (dir ? 32 * MiB : 0));
    const int T = lat ? 1024 : 256; const size_t rowbase = lat ? (size_t)MP + (size_t)b * 1024 : (size_t)b * 256;
    const float g = expf(-expf(a.in(13)[(e * 2 + dir) * 8 + h]));
    const int v = tid & 63, dg = tid >> 6;
    float S[8]; const GAS float* s0p = a.in(3);
#pragma unroll
    for (int i = 0; i < 8; ++i) S[i] = lat ? s0p[((((size_t)(b * 2 + e) * 2 + dir) * 8 + h) * 64 + dg * 8 + i) * 64 + v] : 0.f;
    LAS float* sq = (LAS float*)lds; LAS float* sk = sq + 32 * 64; LAS float* sv = sk + 32 * 64; LAS float* part = sv + 32 * 64;
    const int ltok = tid >> 4, li = tid & 15;
    const float inv = exp2f(-(float)li * (13.287712379549449f / 16.0f));
    for (int c0 = 0; c0 < T; c0 += 32) {
        { const int st = c0 + ltok, n = dir ? T - 1 - st : st; const GAS bf16* zr = Z + (rowbase + n) * NE_IN + h * 64;
#pragma unroll
          for (int hf = 0; hf < 2; ++hf) {
              float q1 = bf2f(zr[1536 + hf * 32 + li]), q2 = bf2f(zr[1536 + hf * 32 + 16 + li]), k1 = bf2f(zr[2048 + hf * 32 + li]), k2 = bf2f(zr[2048 + hf * 32 + 16 + li]);
              if (lat) { const float pos = (float)(hf == 0 ? (n >> 6) : (n & 63)); float sn, cs; sincosf(pos * inv, &sn, &cs);
                  const float a1 = q1 * cs - q2 * sn, a2 = q1 * sn + q2 * cs, b1 = k1 * cs - k2 * sn, b2 = k1 * sn + k2 * cs; q1 = a1; q2 = a2; k1 = b1; k2 = b2; }
              sq[ltok * 64 + hf * 32 + li] = q1; sq[ltok * 64 + hf * 32 + 16 + li] = q2; sk[ltok * 64 + hf * 32 + li] = k1 * 0.125f; sk[ltok * 64 + hf * 32 + 16 + li] = k2 * 0.125f; }
#pragma unroll
          for (int j = 0; j < 4; ++j) sv[ltok * 64 + j * 16 + li] = bf2f(zr[2560 + j * 16 + li]); }
        __syncthreads();
        for (int j = 0; j < 32; ++j) {
            const float vv = sv[j * 64 + v];
            const f32x4 qa = *(const LAS f32x4*)(sq + j * 64 + dg * 8), qb = *(const LAS f32x4*)(sq + j * 64 + dg * 8 + 4), ka = *(const LAS f32x4*)(sk + j * 64 + dg * 8), kb = *(const LAS f32x4*)(sk + j * 64 + dg * 8 + 4);
            const float qq[8] = {qa.x, qa.y, qa.z, qa.w, qb.x, qb.y, qb.z, qb.w}, kk[8] = {ka.x, ka.y, ka.z, ka.w, kb.x, kb.y, kb.z, kb.w};
            float acc = 0.f;
#pragma unroll
            for (int i = 0; i < 8; ++i) { S[i] = g * S[i] + kk[i] * vv; acc += qq[i] * S[i]; }
            part[(j * 8 + dg) * 64 + v] = acc; }
        __syncthreads();
#pragma unroll
        for (int t = 0; t < 4; ++t) { const int idx = tid + NTHREADS * t, tok = idx >> 6, vv = idx & 63; float sum = 0.f;
#pragma unroll
            for (int d8 = 0; d8 < 8; ++d8) sum += part[(tok * 8 + d8) * 64 + vv];
            const int st = c0 + tok, n = dir ? T - 1 - st : st;
            OFB[(rowbase + n) * 1024 + h * 64 + vv] = f2bf16(sum); }
        __syncthreads();
    }
    if (!lat) { GAS float* SR = a.out() + OUT_SR;
#pragma unroll
        for (int i = 0; i < 8; ++i) SR[((((size_t)(b * 2 + e) * 2 + dir) * 8 + h) * 64 + dg * 8 + i) * 64 + v] = S[i]; }
}

__device__ __forceinline__ void hgrn_chain(const Ctx& a, LAS unsigned char* lds, int tid, int oi, bool lat, int b, int h, int dir) {
    const GAS bf16* Z = (const GAS bf16*)(a.ws() + WS_Z); GAS bf16* OFB = (GAS bf16*)(a.ws() + WS_M + (dir ? 32 * MiB : 0));
    const int T = lat ? 1024 : 256; const size_t rowbase = lat ? (size_t)MP + (size_t)b * 1024 : (size_t)b * 256;
    const GAS float* lower = (const GAS float*)(a.ws() + WS_LOWER) + (size_t)(oi * 2 + dir) * 1024 + h * 128;
    const int v = tid & 127, dg = tid >> 7;
    float S[32]; const GAS float* s0p = a.in(4);
#pragma unroll
    for (int i = 0; i < 32; ++i) S[i] = lat ? s0p[((((size_t)(b * 2 + oi) * 2 + dir) * 8 + h) * 128 + dg * 32 + i) * 128 + v] : 0.f;
    LAS float* sq = (LAS float*)lds; LAS float* sf = sq + 16 * 128; LAS float* sk = sf + 16 * 128; LAS float* sv = sk + 16 * 128; LAS float* part = sv + 16 * 128;
    for (int c0 = 0; c0 < T; c0 += 16) {
#pragma unroll
        for (int t = 0; t < 4; ++t) { const int idx = tid + NTHREADS * t, tok = idx >> 7, d = idx & 127; const int st = c0 + tok, n = dir ? T - 1 - st : st;
            const GAS bf16* zr = Z + (rowbase + n) * NO_IN + h * 128 + d;
            const float qr = bf2f(zr[0]), fr = bf2f(zr[1024 + dir * 1024]), vi = bf2f(zr[3072]), lbv = lower[d];
            const float sg = sigmoid_f(fr), sgn = sigmoid_f(-fr);
            sq[idx] = qr * sigmoid_f(qr) * 0.08838834764831845f; sf[idx] = fmaxf(lbv + (1.f - lbv) * sg, 1e-30f); sk[idx] = (1.f - lbv) * sgn; sv[idx] = vi; }
        __syncthreads();
        for (int j = 0; j < 16; ++j) {
            const float vv = sv[j * 128 + v]; float acc = 0.f;
#pragma unroll
            for (int c = 0; c < 8; ++c) { const f32x4 f4 = *(const LAS f32x4*)(sf + j * 128 + dg * 32 + 4 * c), k4 = *(const LAS f32x4*)(sk + j * 128 + dg * 32 + 4 * c), q4 = *(const LAS f32x4*)(sq + j * 128 + dg * 32 + 4 * c);
                S[4 * c] = f4.x * S[4 * c] + k4.x * vv; acc += q4.x * S[4 * c];
                S[4 * c + 1] = f4.y * S[4 * c + 1] + k4.y * vv; acc += q4.y * S[4 * c + 1];
                S[4 * c + 2] = f4.z * S[4 * c + 2] + k4.z * vv; acc += q4.z * S[4 * c + 2];
                S[4 * c + 3] = f4.w * S[4 * c + 3] + k4.w * vv; acc += q4.w * S[4 * c + 3]; }
            part[(j * 4 + dg) * 128 + v] = acc; }
        __syncthreads();
#pragma unroll
        for (int t = 0; t < 4; ++t) { const int idx = tid + NTHREADS * t, tok = idx >> 7, vv = idx & 127;
            const float sum = (part[(tok * 4 + 0) * 128 + vv] + part[(tok * 4 + 1) * 128 + vv]) + (part[(tok * 4 + 2) * 128 + vv] + part[(tok * 4 + 3) * 128 + vv]);
            const int st = c0 + tok, n = dir ? T - 1 - st : st;
            OFB[(rowbase + n) * 1024 + h * 128 + vv] = f2bf16(sum); }
        __syncthreads();
    }
    if (!lat) { GAS float* SH = a.out() + OUT_SH;
#pragma unroll
        for (int i = 0; i < 32; ++i) SH[((((size_t)(b * 2 + oi) * 2 + dir) * 8 + h) * 128 + dg * 32 + i) * 128 + v] = S[i]; }
}

typedef short s16x4 __attribute__((ext_vector_type(4)));
typedef short v4i16_t __attribute__((ext_vector_type(4)));
typedef float f32x16 __attribute__((ext_vector_type(16)));
#define MFMA32(a, b, c) __builtin_amdgcn_mfma_f32_32x32x16_bf16((a), (b), (c), 0, 0, 0)
__device__ __forceinline__ int crow(int r, int hi) { return (r & 3) + 8 * (r >> 2) + 4 * hi; }
__device__ __forceinline__ s16x4 ld_tr(const LAS bf16* p) { return __builtin_bit_cast(s16x4, __builtin_amdgcn_ds_read_tr16_b64_v4i16((LAS v4i16_t*)p)); }
__device__ __forceinline__ bf16x8 frag_row(const LAS bf16* img, int stride, int idx0, int k0, int lane) { return *(const LAS bf16x8*)(img + (idx0 + (lane & 31)) * stride + k0 + 8 * (lane >> 5)); }
__device__ __forceinline__ bf16x8 frag_tr(const LAS bf16* img, int stride, int k0, int idx0, int lane) {
    const int hi = lane >> 5, blk = (lane >> 4) & 1, q = (lane & 15) >> 2, p = lane & 3;
    const LAS bf16* a = img + (k0 + 8 * hi + q) * stride + idx0 + 16 * blk + 4 * p;
    const s16x4 lo = ld_tr(a), hh = ld_tr(a + 4 * stride);
    return (bf16x8){lo[0], lo[1], lo[2], lo[3], hh[0], hh[1], hh[2], hh[3]};
}
__device__ __forceinline__ bf16x8 frag_tr_perm(const LAS bf16* img, int stride, int k0, int idx0, int lane) {
    const int hi = lane >> 5, blk = (lane >> 4) & 1, q = (lane & 15) >> 2, p = lane & 3;
    const LAS bf16* a = img + (k0 + 4 * hi + q) * stride + idx0 + 16 * blk + 4 * p;
    const s16x4 lo = ld_tr(a), hh = ld_tr(a + 8 * stride);
    return (bf16x8){lo[0], lo[1], lo[2], lo[3], hh[0], hh[1], hh[2], hh[3]};
}
__device__ __forceinline__ unsigned pkbf(float lo, float hi) { typedef float f2 __attribute__((ext_vector_type(2))); typedef __bf16 b2 __attribute__((ext_vector_type(2))); const f2 v = {lo, hi}; const b2 b = __builtin_convertvector(v, b2); return __builtin_bit_cast(unsigned, b); }
__device__ __forceinline__ f32x16 zero16() { f32x16 z;
#pragma unroll
    for (int i = 0; i < 16; ++i) z[i] = 0.f; return z; }

constexpr int HG_RS = 136, HG_PS = 72;
constexpr int HG_QH = 0, HG_KH = HG_QH + 64 * HG_RS * 2, HG_V = HG_KH + 64 * HG_RS * 2, HG_SI = HG_V + 64 * HG_RS * 2, HG_P = HG_SI + 128 * HG_RS * 2, HG_BM = HG_P + 64 * HG_PS * 2, HG_BL = HG_BM + 512, HG_QT = HG_BL + 512, HG_END = HG_QT + 2048;
static_assert(HG_END <= RING_BYTES, "HGRN LDS map");
__device__ __forceinline__ float clamp80(float x) { return fminf(fmaxf(x, -80.f), 80.f); }
__device__ __forceinline__ void hgrn_chain_mfma(const Ctx& a, LAS unsigned char* lds, int tid, int oi, bool lat, int b, int h, int dir) {
    const GAS bf16* Z = (const GAS bf16*)(a.ws() + WS_Z); GAS bf16* OFB = (GAS bf16*)(a.ws() + WS_M + (dir ? 32 * MiB : 0));
    const int T = lat ? 1024 : 256; const size_t rowbase = lat ? (size_t)MP + (size_t)b * 1024 : (size_t)b * 256;
    const int lane = tid & 63, w = __builtin_amdgcn_readfirstlane(tid >> 6), hi = lane >> 5, l31 = lane & 31;
    LAS bf16* QH = (LAS bf16*)(lds + HG_QH); LAS bf16* KH = (LAS bf16*)(lds + HG_KH); LAS bf16* VV = (LAS bf16*)(lds + HG_V); LAS bf16* SI = (LAS bf16*)(lds + HG_SI); LAS bf16* PP = (LAS bf16*)(lds + HG_P);
    LAS float* BM = (LAS float*)(lds + HG_BM); LAS float* BL = (LAS float*)(lds + HG_BL); LAS float* QT = (LAS float*)(lds + HG_QT);
    const int d = tid & 127, qtr = tid >> 7;
    const float lbv = ((const GAS float*)(a.ws() + WS_LOWER))[(size_t)(oi * 2 + dir) * 1024 + h * 128 + d];
    const int dkb = w & 3, dvb0 = 2 * (w >> 2);
    f32x16 S0, S1;
    if (lat) { const GAS float* s0p = a.in(4) + ((((size_t)(b * 2 + oi) * 2 + dir) * 8 + h) * 128 + 32 * dkb + l31) * 128;
#pragma unroll
        for (int g = 0; g < 4; ++g) { const f32x4 x0 = *(const GAS f32x4*)(s0p + 32 * dvb0 + 8 * g + 4 * hi), x1 = *(const GAS f32x4*)(s0p + 32 * (dvb0 + 1) + 8 * g + 4 * hi);
            S0[4 * g] = x0.x; S0[4 * g + 1] = x0.y; S0[4 * g + 2] = x0.z; S0[4 * g + 3] = x0.w; S1[4 * g] = x1.x; S1[4 * g + 1] = x1.y; S1[4 * g + 2] = x1.z; S1[4 * g + 3] = x1.w; }
    } else { S0 = zero16(); S1 = zero16(); }
    for (int c0 = 0; c0 < T; c0 += 64) {
        { v4u rq[2], rf[2], rv[2];
#pragma unroll
          for (int j = 0; j < 2; ++j) { const int pc = tid + NTHREADS * j, tok = pc >> 4, c16 = pc & 15; const int st = c0 + tok, n = dir ? T - 1 - st : st;
              const GAS bf16* zr = Z + (rowbase + n) * NO_IN + h * 128 + 8 * c16;
              rq[j] = *(const GAS v4u*)zr; rf[j] = *(const GAS v4u*)(zr + 1024 + dir * 1024); rv[j] = *(const GAS v4u*)(zr + 3072); }
#pragma unroll
          for (int j = 0; j < 2; ++j) { const int pc = tid + NTHREADS * j, tok = pc >> 4, c16 = pc & 15;
              *(LAS v4u*)(QH + tok * HG_RS + 8 * c16) = rq[j]; *(LAS v4u*)(KH + tok * HG_RS + 8 * c16) = rf[j]; *(LAS v4u*)(VV + tok * HG_RS + 8 * c16) = rv[j]; } }
        __syncthreads();
        float qv[16], kv[16], cb[16]; float run = 0.f;
#pragma unroll
        for (int i = 0; i < 16; ++i) { const int t = 16 * qtr + i;
            const float qr = bf2f(QH[t * HG_RS + d]), fr = fmaxf(bf2f(KH[t * HG_RS + d]), -80.f);
            const float ef = __builtin_amdgcn_exp2f(fr * -1.4426950408889634f), rf_ = __builtin_amdgcn_rcpf(1.f + ef), sg = rf_, sgn = ef * rf_;
            const float f = fmaxf(lbv + (1.f - lbv) * sg, 1e-30f);
            run += __builtin_amdgcn_logf(f) * 0.6931471805599453f; cb[i] = run; kv[i] = (1.f - lbv) * sgn;
            const float eq = __builtin_amdgcn_exp2f(fmaxf(qr, -80.f) * -1.4426950408889634f); qv[i] = qr * __builtin_amdgcn_rcpf(1.f + eq) * 0.08838834764831845f; }
        QT[qtr * 128 + d] = run;
        __syncthreads();
        const float t0 = QT[d], t1 = QT[128 + d], t2 = QT[256 + d], t3 = QT[384 + d];
        const float off = (qtr > 0 ? t0 : 0.f) + (qtr > 1 ? t1 : 0.f) + (qtr > 2 ? t2 : 0.f), bmid = t0 + t1, blast = (t0 + t1) + (t2 + t3);
#pragma unroll
        for (int i = 0; i < 16; ++i) { const float bt = off + cb[i]; const int t = 16 * qtr + i;
            const float e1 = __builtin_amdgcn_exp2f(clamp80(bt - bmid) * 1.4426950408889634f), e2 = __builtin_amdgcn_exp2f(clamp80(bmid - bt) * 1.4426950408889634f);
            const unsigned pk = pkbf(qv[i] * e1, kv[i] * e2);
            QH[t * HG_RS + d] = (unsigned short)(pk & 0xffffu); KH[t * HG_RS + d] = (unsigned short)(pk >> 16); }
        if (qtr == 0) { BM[d] = bmid; BL[d] = blast; }
        __syncthreads();
        const float bm_l = BM[32 * dkb + l31], bl_l = BL[32 * dkb + l31], em = __expf(clamp80(bm_l));
#pragma unroll
        for (int g = 0; g < 4; ++g) {
            *(LAS unsigned long long*)(SI + (32 * dkb + l31) * HG_RS + 32 * dvb0 + 8 * g + 4 * hi) = (unsigned long long)pkbf(S0[4 * g] * em, S0[4 * g + 1] * em) | ((unsigned long long)pkbf(S0[4 * g + 2] * em, S0[4 * g + 3] * em) << 32);
            *(LAS unsigned long long*)(SI + (32 * dkb + l31) * HG_RS + 32 * (dvb0 + 1) + 8 * g + 4 * hi) = (unsigned long long)pkbf(S1[4 * g] * em, S1[4 * g + 1] * em) | ((unsigned long long)pkbf(S1[4 * g + 2] * em, S1[4 * g + 3] * em) << 32); }
        { f32x16 u0 = zero16(), u1 = zero16();
#pragma unroll
          for (int ks = 0; ks < 4; ++ks) { const bf16x8 bk = frag_tr(KH, HG_RS, 16 * ks, 32 * dkb, lane);
              u0 = MFMA32(frag_tr(VV, HG_RS, 16 * ks, 32 * dvb0, lane), bk, u0); u1 = MFMA32(frag_tr(VV, HG_RS, 16 * ks, 32 * (dvb0 + 1), lane), bk, u1); }
          const float e1 = __expf(clamp80(bl_l)), e2 = __expf(clamp80(bl_l - bm_l));
#pragma unroll
          for (int r = 0; r < 16; ++r) { S0[r] = S0[r] * e1 + u0[r] * e2; S1[r] = S1[r] * e1 + u1[r] * e2; } }
        if (w < 3) { const int tb = (w == 0) ? 0 : 1, sb = (w == 2) ? 1 : 0; f32x16 p = zero16();
#pragma unroll
            for (int ks = 0; ks < 8; ++ks) p = MFMA32(frag_row(KH, HG_RS, 32 * sb, 16 * ks, lane), frag_row(QH, HG_RS, 32 * tb, 16 * ks, lane), p);
            const int t = 32 * tb + l31;
#pragma unroll
            for (int g = 0; g < 4; ++g) { float x[4];
#pragma unroll
                for (int i = 0; i < 4; ++i) { const int s = 32 * sb + 8 * g + 4 * hi + i; x[i] = (s <= t) ? p[4 * g + i] : 0.f; }
                *(LAS unsigned long long*)(PP + t * HG_PS + 32 * sb + 8 * g + 4 * hi) = (unsigned long long)pkbf(x[0], x[1]) | ((unsigned long long)pkbf(x[2], x[3]) << 32); } }
        __syncthreads();
        { const int tb = w & 1, dvb = w >> 1; f32x16 o = zero16();
#pragma unroll
          for (int ks = 0; ks < 8; ++ks) o = MFMA32(frag_row(QH, HG_RS, 32 * tb, 16 * ks, lane), frag_tr(SI, HG_RS, 16 * ks, 32 * dvb, lane), o);
          const int nks = tb ? 4 : 2;
          for (int ks = 0; ks < nks; ++ks) o = MFMA32(frag_row(PP, HG_PS, 32 * tb, 16 * ks, lane), frag_tr(VV, HG_RS, 16 * ks, 32 * dvb, lane), o);
#pragma unroll
          for (int r = 0; r < 16; ++r) { const int st = c0 + 32 * tb + crow(r, hi), n = dir ? T - 1 - st : st;
              OFB[(rowbase + n) * 1024 + h * 128 + 32 * dvb + l31] = f2bf16(o[r]); } }
        __syncthreads();
    }
    if (!lat) { GAS float* sp = a.out() + OUT_SH + ((((size_t)(b * 2 + oi) * 2 + dir) * 8 + h) * 128 + 32 * dkb + l31) * 128;
#pragma unroll
        for (int g = 0; g < 4; ++g) { *(GAS f32x4*)(sp + 32 * dvb0 + 8 * g + 4 * hi) = (f32x4){S0[4 * g], S0[4 * g + 1], S0[4 * g + 2], S0[4 * g + 3]};
            *(GAS f32x4*)(sp + 32 * (dvb0 + 1) + 8 * g + 4 * hi) = (f32x4){S1[4 * g], S1[4 * g + 1], S1[4 * g + 2], S1[4 * g + 3]}; } }
}

constexpr int AT_RS = 72;
typedef unsigned u32x4 __attribute__((ext_vector_type(4)));
__device__ __forceinline__ bf16x8 pack8(const f32x16& x, int s) { u32x4 p; p.x = pkbf(x[8 * s], x[8 * s + 1]); p.y = pkbf(x[8 * s + 2], x[8 * s + 3]); p.z = pkbf(x[8 * s + 4], x[8 * s + 5]); p.w = pkbf(x[8 * s + 6], x[8 * s + 7]); return __builtin_bit_cast(bf16x8, p); }
__device__ __forceinline__ float xor32(float v) { return __shfl_xor(v, 32); }
template <int NT> __device__ __forceinline__ void qk_lds(f32x16 (&S)[NT], const LAS bf16* KI, int key0, const bf16x8 (&qf)[4], int lane) {
#pragma unroll
    for (int t = 0; t < NT; ++t) { S[t] = zero16();
#pragma unroll
        for (int s = 0; s < 4; ++s) S[t] = MFMA32(frag_row(KI, AT_RS, key0 + 32 * t, 16 * s, lane), qf[s], S[t]); }
}
template <int NT> __device__ __forceinline__ void pv_lds(f32x16 (&o)[2], const f32x16 (&P)[NT], const LAS bf16* VI, int key0, int lane) {
#pragma unroll
    for (int t = 0; t < NT; ++t)
#pragma unroll
        for (int ks = 0; ks < 2; ++ks) { const bf16x8 pb = pack8(P[t], ks);
            o[0] = MFMA32(frag_tr_perm(VI, AT_RS, key0 + 32 * t + 16 * ks, 0, lane), pb, o[0]); o[1] = MFMA32(frag_tr_perm(VI, AT_RS, key0 + 32 * t + 16 * ks, 32, lane), pb, o[1]); }
}
__device__ __forceinline__ void stage_tile256(LAS bf16* img, const GAS bf16* src, int pitch, int tid) {
    v4u r[4];
#pragma unroll
    for (int j = 0; j < 4; ++j) { const int pc = tid + NTHREADS * j; r[j] = *(const GAS v4u*)(src + (size_t)(pc >> 3) * pitch + 8 * (pc & 7)); }
#pragma unroll
    for (int j = 0; j < 4; ++j) { const int pc = tid + NTHREADS * j; *(LAS v4u*)(img + (pc >> 3) * AT_RS + 8 * (pc & 7)) = r[j]; }
}
__device__ __forceinline__ void store_o4(GAS bf16* p, float a0, float a1, float a2, float a3) { *(GAS unsigned long long*)p = (unsigned long long)pkbf(a0, a1) | ((unsigned long long)pkbf(a2, a3) << 32); }

constexpr int EV_K = 0, EV_V = 36864, EV_S0 = 73728, EV_ROPE = 110592, EV_RPB = 118784;

__device__ __forceinline__ void ctx_attn_mfma(const Ctx& a, LAS unsigned char* lds, int tid, int b, int h) {
    const GAS bf16* Z = (const GAS bf16*)(a.ws() + WS_Z); GAS bf16* O = (GAS bf16*)(a.ws() + WS_H);
    const int lane = tid & 63, w = __builtin_amdgcn_readfirstlane(tid >> 6), hi = lane >> 5, l31 = lane & 31;
    LAS bf16* KI = (LAS bf16*)(lds + EV_K); LAS bf16* VI = (LAS bf16*)(lds + EV_V);
    const size_t rb = (size_t)b * 256;
    stage_tile256(KI, Z + rb * NE_IN + 512 + h * 64, NE_IN, tid); stage_tile256(VI, Z + rb * NE_IN + 1024 + h * 64, NE_IN, tid);
    const size_t qrow = rb + 32 * w + l31;
    bf16x8 qf[4];
#pragma unroll
    for (int s = 0; s < 4; ++s) qf[s] = *(const GAS bf16x8*)(Z + qrow * NE_IN + h * 64 + 16 * s + 8 * hi);
    __syncthreads();
    f32x16 S[8]; qk_lds<8>(S, KI, 0, qf, lane);
    float m = -INFINITY;
#pragma unroll
    for (int t = 0; t < 8; ++t)
#pragma unroll
        for (int r = 0; r < 16; ++r) m = fmaxf(m, S[t][r]);
    m = fmaxf(m, xor32(m));
    const float c = 0.125f * 1.4426950408889634f; float l = 0.f;
#pragma unroll
    for (int t = 0; t < 8; ++t)
#pragma unroll
        for (int r = 0; r < 16; ++r) { const float p = __builtin_amdgcn_exp2f((S[t][r] - m) * c); S[t][r] = p; l += p; }
    l += xor32(l);
    f32x16 o[2]; o[0] = zero16(); o[1] = zero16();
    pv_lds<8>(o, S, VI, 0, lane);
    const float rl = 1.0f / l;
#pragma unroll
    for (int db = 0; db < 2; ++db)
#pragma unroll
        for (int g = 0; g < 4; ++g) store_o4(O + qrow * 1024 + h * 64 + 32 * db + 8 * g + 4 * hi, o[db][4 * g] * rl, o[db][4 * g + 1] * rl, o[db][4 * g + 2] * rl, o[db][4 * g + 3] * rl);
    __syncthreads();
}

__device__ __forceinline__ void ret_unit_mfma(const Ctx& a, LAS unsigned char* lds, int tid, int e, bool lat, int b, int h, int qt) {
    const GAS bf16* Z = (const GAS bf16*)(a.ws() + WS_Z); GAS bf16* O = (GAS bf16*)(a.ws() + WS_H);
    const int lane = tid & 63, w = __builtin_amdgcn_readfirstlane(tid >> 6), hi = lane >> 5, l31 = lane & 31;
    LAS bf16* KI = (LAS bf16*)(lds + EV_K); LAS bf16* VI = (LAS bf16*)(lds + EV_V); LAS bf16* S0I = (LAS bf16*)(lds + EV_S0);
    const LAS float* RT = (const LAS float*)(lds + EV_ROPE);
    const int T = lat ? 1024 : 256; const size_t rowbase = lat ? (size_t)MP + (size_t)b * 1024 : (size_t)b * 256;
    const GAS float* rd = a.in(13) + (e * 2) * 8 + h;
    const float lgf = -expf(rd[0]) * 1.4426950408889634f, lgb = -expf(rd[8]) * 1.4426950408889634f;
    const int nq = 256 * qt + 32 * w + l31; const size_t qrow = rowbase + nq;
    bf16x8 qf[4];
#pragma unroll
    for (int s = 0; s < 4; ++s) qf[s] = *(const GAS bf16x8*)(Z + qrow * NE_IN + 1536 + h * 64 + 16 * s + 8 * hi);
    if (lat) {
#pragma unroll
        for (int pr = 0; pr < 2; ++pr) { const int pos = pr ? (nq & 63) : (nq >> 6);
#pragma unroll
            for (int j = 0; j < 8; ++j) { const float cs = RT[(pos * 16 + 8 * hi + j) * 2], sn = RT[(pos * 16 + 8 * hi + j) * 2 + 1];
                const float x1 = bf2f((unsigned short)qf[2 * pr][j]), x2 = bf2f((unsigned short)qf[2 * pr + 1][j]);
                qf[2 * pr][j] = (short)f2bf16(x1 * cs - x2 * sn); qf[2 * pr + 1][j] = (short)f2bf16(x1 * sn + x2 * cs); } }
    }
    if (lat) {
        const int idx = tid * 16, dr = idx >> 12, dk = (idx >> 6) & 63, dv0 = idx & 63;
        const GAS float* sp = a.in(3) + ((((size_t)(b * 2 + e) * 2 + dr) * 8 + h) * 64 + dk) * 64 + dv0;
        const f32x4 x0 = *(const GAS f32x4*)sp, x1 = *(const GAS f32x4*)(sp + 4), x2 = *(const GAS f32x4*)(sp + 8), x3 = *(const GAS f32x4*)(sp + 12);
        v4u w1, w2; w1.x = pkbf(x0.x, x0.y); w1.y = pkbf(x0.z, x0.w); w1.z = pkbf(x1.x, x1.y); w1.w = pkbf(x1.z, x1.w); w2.x = pkbf(x2.x, x2.y); w2.y = pkbf(x2.z, x2.w); w2.z = pkbf(x3.x, x3.y); w2.w = pkbf(x3.z, x3.w);
        *(LAS v4u*)(S0I + (dr * 64 + dk) * AT_RS + dv0) = w1; *(LAS v4u*)(S0I + (dr * 64 + dk) * AT_RS + dv0 + 8) = w2; }
    f32x16 o[2]; o[0] = zero16(); o[1] = zero16();
    const int nkt = T >> 8;
    for (int kt = 0; kt < nkt; ++kt) {
        __syncthreads();
        if (!lat) { stage_tile256(KI, Z + rowbase * NE_IN + 2048 + h * 64, NE_IN, tid); }
        else {
#pragma unroll
            for (int jj = 0; jj < 2; ++jj) { const int pc = tid + NTHREADS * jj, key = pc >> 2, hf = (pc >> 1) & 1, ig = pc & 1; const int mk = 256 * kt + key;
                const GAS bf16* src = Z + (rowbase + mk) * NE_IN + 2048 + h * 64 + 32 * hf + 8 * ig;
                float x1[8], x2[8]; unpack8(*(const GAS v4u*)src, x1); unpack8(*(const GAS v4u*)(src + 16), x2);
                const int pos = hf ? (mk & 63) : (mk >> 6); float y1[8], y2[8];
#pragma unroll
                for (int j = 0; j < 8; ++j) { const float cs = RT[(pos * 16 + 8 * ig + j) * 2], sn = RT[(pos * 16 + 8 * ig + j) * 2 + 1]; y1[j] = x1[j] * cs - x2[j] * sn; y2[j] = x1[j] * sn + x2[j] * cs; }
                v4u w1, w2; w1.x = pkbf(y1[0], y1[1]); w1.y = pkbf(y1[2], y1[3]); w1.z = pkbf(y1[4], y1[5]); w1.w = pkbf(y1[6], y1[7]); w2.x = pkbf(y2[0], y2[1]); w2.y = pkbf(y2[2], y2[3]); w2.z = pkbf(y2[4], y2[5]); w2.w = pkbf(y2[6], y2[7]);
                *(LAS v4u*)(KI + key * AT_RS + 32 * hf + 8 * ig) = w1; *(LAS v4u*)(KI + key * AT_RS + 32 * hf + 16 + 8 * ig) = w2; }
        }
        stage_tile256(VI, Z + (rowbase + 256 * kt) * NE_IN + 2560 + h * 64, NE_IN, tid);
        __syncthreads();
#pragma unroll 1
        for (int t2 = 0; t2 < 4; ++t2) { f32x16 S[2]; qk_lds<2>(S, KI, 64 * t2, qf, lane);
#pragma unroll
            for (int t = 0; t < 2; ++t)
#pragma unroll
                for (int r = 0; r < 16; ++r) { const int mk = 256 * kt + 64 * t2 + 32 * t + crow(r, hi), dl = nq - mk;
                    const float dec = dl > 0 ? __builtin_amdgcn_exp2f(lgf * (float)dl) : (dl < 0 ? __builtin_amdgcn_exp2f(lgb * (float)(-dl)) : 2.0f);
                    S[t][r] *= 0.125f * dec; }
            pv_lds<2>(o, S, VI, 64 * t2, lane); }
    }
    if (lat) {
        const float cf = __builtin_amdgcn_exp2f(lgf * (float)(nq + 1)), cb = __builtin_amdgcn_exp2f(lgb * (float)(T - nq));
#pragma unroll
        for (int dr = 0; dr < 2; ++dr)
#pragma unroll
            for (int db = 0; db < 2; ++db) { f32x16 t = zero16();
#pragma unroll
                for (int s = 0; s < 4; ++s) t = MFMA32(frag_tr(S0I + dr * 64 * AT_RS, AT_RS, 16 * s, 32 * db, lane), qf[s], t);
                const float cc = dr ? cb : cf;
#pragma unroll
                for (int r = 0; r < 16; ++r) o[db][r] += cc * t[r]; }
    }
    float ss = 0.f;
#pragma unroll
    for (int db = 0; db < 2; ++db)
#pragma unroll
        for (int r = 0; r < 16; ++r) ss += o[db][r] * o[db][r];
    ss += xor32(ss);
    const float rstd = rsqrtf(ss * (1.f / 64.f) + EPS_N);
#pragma unroll
    for (int db = 0; db < 2; ++db)
#pragma unroll
        for (int g = 0; g < 4; ++g) { const int dv = 32 * db + 8 * g + 4 * hi; const unsigned long long gw = *(const GAS unsigned long long*)(Z + qrow * NE_IN + 3072 + h * 64 + dv);
            const float g0 = __uint_as_float((unsigned)gw << 16), g1 = __uint_as_float((unsigned)gw & 0xffff0000u), g2 = __uint_as_float((unsigned)(gw >> 32) << 16), g3 = __uint_as_float((unsigned)(gw >> 32) & 0xffff0000u);
            store_o4(O + qrow * 1024 + 512 + h * 64 + dv, o[db][4 * g] * rstd * g0 * sigmoid_f(g0), o[db][4 * g + 1] * rstd * g1 * sigmoid_f(g1), o[db][4 * g + 2] * rstd * g2 * sigmoid_f(g2), o[db][4 * g + 3] * rstd * g3 * sigmoid_f(g3)); }
    if (!lat) {
        const int dr = w >> 2, dkb = (w >> 1) & 1, dvb = w & 1; f32x16 st = zero16(); const float lg = dr ? lgb : lgf;
#pragma unroll 4
        for (int ks = 0; ks < 16; ++ks) { bf16x8 ak = frag_tr(KI, AT_RS, 16 * ks, 32 * dkb, lane);
            u32x4 sc;
#pragma unroll
            for (int jp = 0; jp < 4; ++jp) { const int m0 = 16 * ks + 8 * hi + 2 * jp;
                const float w0 = 0.125f * __builtin_amdgcn_exp2f(lg * (float)(dr ? m0 : 255 - m0)), w1 = 0.125f * __builtin_amdgcn_exp2f(lg * (float)(dr ? m0 + 1 : 254 - m0));
                sc[jp] = pkbf(bf2f((unsigned short)ak[2 * jp]) * w0, bf2f((unsigned short)ak[2 * jp + 1]) * w1); }
            st = MFMA32(__builtin_bit_cast(bf16x8, sc), frag_tr(VI, AT_RS, 16 * ks, 32 * dvb, lane), st); }
        GAS float* sp = a.out() + OUT_SR + ((((size_t)(b * 2 + e) * 2 + dr) * 8 + h) * 64) * 64;
#pragma unroll
        for (int r = 0; r < 16; ++r) sp[(32 * dkb + crow(r, hi)) * 64 + 32 * dvb + l31] = st[r];
    }
    __syncthreads();
}

constexpr int NA_VL = 0, NA_VC = 73728;
__device__ __forceinline__ void na_stage_ctx(const Ctx& a, LAS unsigned char* lds, int tid, int e, int b, int h) {
    const GAS float* cv = a.in(2) + ((((size_t)(b * 2 + e) * 2 + 1) * 8 + h) * 256) * 64; LAS bf16* VC = (LAS bf16*)(lds + NA_VC);
#pragma unroll
    for (int j = 0; j < 4; ++j) { const int pc = tid + NTHREADS * j, key = pc >> 3, c8 = pc & 7; const f32x4 x0 = *(const GAS f32x4*)(cv + key * 64 + 8 * c8), x1 = *(const GAS f32x4*)(cv + key * 64 + 8 * c8 + 4);
        v4u wv; wv.x = pkbf(x0.x, x0.y); wv.y = pkbf(x0.z, x0.w); wv.z = pkbf(x1.x, x1.y); wv.w = pkbf(x1.z, x1.w); *(LAS v4u*)(VC + key * AT_RS + 8 * c8) = wv; }
    const GAS float* rp = a.in(12) + (size_t)(e * 8 + h) * 465; LAS float* RP = (LAS float*)(lds + EV_RPB);
    if (tid < 465) RP[tid] = rp[tid];
}
__device__ __forceinline__ void na_unit_mfma(const Ctx& a, LAS unsigned char* lds, int tid, int e, int b, int h, int r) {
    const GAS bf16* Z = (const GAS bf16*)(a.ws() + WS_Z); GAS bf16* O = (GAS bf16*)(a.ws() + WS_H);
    const int lane = tid & 63, w = __builtin_amdgcn_readfirstlane(tid >> 6), hi = lane >> 5, l31 = lane & 31;
    const int qt = w & 1, kp = w >> 1;
    LAS bf16* VL = (LAS bf16*)(lds + NA_VL); const LAS bf16* VC = (const LAS bf16*)(lds + NA_VC); const LAS float* RP = (const LAS float*)(lds + EV_RPB);
    const size_t lb = (size_t)MP + (size_t)b * 1024; const int kr0 = min(max(r - 4, 0), 8);
    __syncthreads();
    { v4u rr[8];
#pragma unroll
      for (int j = 0; j < 8; ++j) { const int pc = tid + NTHREADS * j, key = pc >> 3; rr[j] = *(const GAS v4u*)(Z + (lb + kr0 * 64 + key) * NE_IN + 1024 + h * 64 + 8 * (pc & 7)); }
#pragma unroll
      for (int j = 0; j < 8; ++j) { const int pc = tid + NTHREADS * j; *(LAS v4u*)(VL + (pc >> 3) * AT_RS + 8 * (pc & 7)) = rr[j]; } }
    const int qc = 32 * qt + l31; const size_t qrow = lb + r * 64 + qc;
    bf16x8 qf[4];
#pragma unroll
    for (int s = 0; s < 4; ++s) qf[s] = *(const GAS bf16x8*)(Z + qrow * NE_IN + h * 64 + 16 * s + 8 * hi);
    f32x16 S[6];
#pragma unroll
    for (int t = 0; t < 4; ++t) { const int p = 2 * kp + (t >> 1), kc0 = 32 * (t & 1); const GAS bf16* kr = Z + (lb + (kr0 + p) * 64 + kc0 + l31) * NE_IN + 512 + h * 64 + 8 * hi;
        S[t] = zero16();
#pragma unroll
        for (int s = 0; s < 4; ++s) S[t] = MFMA32(*(const GAS bf16x8*)(kr + 16 * s), qf[s], S[t]); }
    const GAS float* ck = a.in(2) + ((((size_t)(b * 2 + e) * 2 + 0) * 8 + h) * 256) * 64;
#pragma unroll
    for (int t = 0; t < 2; ++t) { const GAS float* kr = ck + (size_t)(64 * kp + 32 * t + l31) * 64 + 8 * hi; S[4 + t] = zero16();
#pragma unroll
        for (int s = 0; s < 4; ++s) { const f32x4 x0 = *(const GAS f32x4*)(kr + 16 * s), x1 = *(const GAS f32x4*)(kr + 16 * s + 4);
            u32x4 kk; kk.x = pkbf(x0.x, x0.y); kk.y = pkbf(x0.z, x0.w); kk.z = pkbf(x1.x, x1.y); kk.w = pkbf(x1.z, x1.w);
            S[4 + t] = MFMA32(__builtin_bit_cast(bf16x8, kk), qf[s], S[4 + t]); } }
    const int win0 = min(max(qc - 8, 0), 48);
    float m = -INFINITY;
#pragma unroll
    for (int t = 0; t < 4; ++t) { const int p = 2 * kp + (t >> 1), ro = (kr0 + p) - r + 7;
#pragma unroll
        for (int rg = 0; rg < 16; ++rg) { const int kc = 32 * (t & 1) + crow(rg, hi); const bool ok = (kc >= win0) && (kc < win0 + 16);
            const float bias = RP[ro * 31 + min(max(kc - qc + 15, 0), 30)];
            const float sv = ok ? S[t][rg] * 0.125f + bias : -1e30f; S[t][rg] = sv; m = fmaxf(m, sv); } }
#pragma unroll
    for (int t = 4; t < 6; ++t)
#pragma unroll
        for (int rg = 0; rg < 16; ++rg) { const float sv = S[t][rg] * 0.125f; S[t][rg] = sv; m = fmaxf(m, sv); }
    m = fmaxf(m, xor32(m));
    float l = 0.f;
#pragma unroll
    for (int t = 0; t < 6; ++t)
#pragma unroll
        for (int rg = 0; rg < 16; ++rg) { const float pv = __builtin_amdgcn_exp2f((S[t][rg] - m) * 1.4426950408889634f); S[t][rg] = pv; l += pv; }
    l += xor32(l);
    __syncthreads();
    f32x16 o[2]; o[0] = zero16(); o[1] = zero16();
#pragma unroll
    for (int t = 0; t < 6; ++t) { const LAS bf16* VI = (t < 4) ? VL : VC; const int key0 = (t < 4) ? (2 * kp + (t >> 1)) * 64 + 32 * (t & 1) : 64 * kp + 32 * (t - 4);
#pragma unroll
        for (int ks = 0; ks < 2; ++ks) { const bf16x8 pb = pack8(S[t], ks);
            o[0] = MFMA32(frag_tr_perm(VI, AT_RS, key0 + 16 * ks, 0, lane), pb, o[0]); o[1] = MFMA32(frag_tr_perm(VI, AT_RS, key0 + 16 * ks, 32, lane), pb, o[1]); } }
    __syncthreads();
    LAS float* MA = (LAS float*)(lds + NA_VL) + w * 2176;
    if (hi == 0) { MA[l31] = m; MA[32 + l31] = l; }
#pragma unroll
    for (int db = 0; db < 2; ++db)
#pragma unroll
        for (int rg = 0; rg < 16; ++rg) MA[64 + (32 * db + crow(rg, hi)) * 32 + l31] = o[db][rg];
    __syncthreads();
    { const LAS float* M0 = (const LAS float*)(lds + NA_VL) + qt * 2176; float mk[4], lk[4], mm = -INFINITY;
#pragma unroll
      for (int k = 0; k < 4; ++k) { mk[k] = M0[k * 2 * 2176 + l31]; lk[k] = M0[k * 2 * 2176 + 32 + l31]; mm = fmaxf(mm, mk[k]); }
      float L = 0.f, ak[4];
#pragma unroll
      for (int k = 0; k < 4; ++k) { ak[k] = __builtin_amdgcn_exp2f((mk[k] - mm) * 1.4426950408889634f); L += ak[k] * lk[k]; }
      const float rL = 1.0f / L; float od[8];
#pragma unroll
      for (int i = 0; i < 8; ++i) { const int dd = 16 * kp + 8 * hi + i; float acc = 0.f;
#pragma unroll
          for (int k = 0; k < 4; ++k) acc += ak[k] * M0[k * 2 * 2176 + 64 + dd * 32 + l31];
          od[i] = acc * rL; }
      v4u wv; wv.x = pkbf(od[0], od[1]); wv.y = pkbf(od[2], od[3]); wv.z = pkbf(od[4], od[5]); wv.w = pkbf(od[6], od[7]);
      *(GAS v4u*)(O + qrow * 1024 + h * 64 + 16 * kp + 8 * hi) = wv; }
}

__device__ __forceinline__ void phase_mix_even(const Ctx& a, LAS unsigned char* lds, int tid, int bid, int G, int e) {
    { LAS float* RT = (LAS float*)(lds + EV_ROPE);
      for (int i = tid; i < 1024; i += NTHREADS) { float sn, cs; sincosf((float)(i >> 4) * exp2f(-(float)(i & 15) * (13.287712379549449f / 16.0f)), &sn, &cs); RT[2 * i] = cs; RT[2 * i + 1] = sn; } }
    __syncthreads();
    for (int u = bid; u < 256; u += G) ctx_attn_mfma(a, lds, tid, u >> 3, u & 7);
#pragma unroll 1
    for (int u2 = bid; u2 < 512; u2 += G) { int lat = u2 >> 8; asm volatile("" : "+s"(lat)); const int u = u2 & 255;
        ret_unit_mfma(a, lds, tid, e, lat != 0, lat ? (u >> 5) : (u >> 3), lat ? ((u >> 2) & 7) : (u & 7), lat ? (u & 3) : 0); }
    for (int u = bid; u < 256; u += G) { const int b = u >> 5, h = (u >> 2) & 7; __syncthreads(); na_stage_ctx(a, lds, tid, e, b, h);
        for (int i = 0; i < 4; ++i) na_unit_mfma(a, lds, tid, e, b, h, 4 * i + (u & 3)); }
    __syncthreads();
}
__device__ __forceinline__ void phase_mix_odd(const Ctx& a, LAS unsigned char* lds, int tid, int bid, int G, int oi) {
    for (int s = bid; s < 256; s += G) {
        if (s < 128) hgrn_chain_mfma(a, lds, tid, oi, true, s >> 4, (s >> 1) & 7, s & 1);
        else for (int j = 0; j < 4; ++j) { const int pc = (s - 128) * 4 + j; hgrn_chain_mfma(a, lds, tid, oi, false, pc >> 4, (pc >> 1) & 7, pc & 1); } }
}
__device__ __forceinline__ void phase_fin(const Ctx& a, int l, int lane, int gw, int NGW) {
    const GAS bf16* Z = (const GAS bf16*)(a.ws() + WS_Z); const GAS bf16* OF = (const GAS bf16*)(a.ws() + WS_M); const GAS bf16* OB = (const GAS bf16*)(a.ws() + WS_M + 32 * MiB); GAS bf16* O = (GAS bf16*)(a.ws() + WS_H);
    const int head = lane >> 3, sub = lane & 7;
    if ((l & 1) == 0) {
        for (int row = gw; row < MROWS; row += NGW) { const int c0 = head * 64 + sub * 8;
            float f1[8], f2[8], gg[8]; unpack8(*(const GAS v4u*)(OF + (size_t)row * 1024 + c0), f1); unpack8(*(const GAS v4u*)(OB + (size_t)row * 1024 + c0), f2); unpack8(*(const GAS v4u*)(Z + (size_t)row * NE_IN + 3072 + c0), gg);
            float ss = 0.f;
#pragma unroll
            for (int i = 0; i < 8; ++i) { f1[i] += f2[i]; ss += f1[i] * f1[i]; }
            ss += __shfl_xor(ss, 1); ss += __shfl_xor(ss, 2); ss += __shfl_xor(ss, 4);
            const float rstd = rsqrtf(ss * (1.f / 64.f) + EPS_N);
#pragma unroll
            for (int i = 0; i < 8; ++i) f1[i] = f1[i] * rstd * (gg[i] * sigmoid_f(gg[i]));
            v4u w; w.x = pk2(f1[0], f1[1]); w.y = pk2(f1[2], f1[3]); w.z = pk2(f1[4], f1[5]); w.w = pk2(f1[6], f1[7]);
            *(GAS v4u*)(O + (size_t)row * 1024 + 512 + c0) = w; }
    } else {
        const int oi = l >> 1; const GAS float* gn = a.in(17) + oi * 128 + sub * 16;
        for (int row = gw; row < MROWS; row += NGW) { const int c0 = head * 128 + sub * 16;
            float f[16]; float ss = 0.f;
#pragma unroll
            for (int hh = 0; hh < 2; ++hh) { float f1[8], f2[8]; unpack8(*(const GAS v4u*)(OF + (size_t)row * 1024 + c0 + 8 * hh), f1); unpack8(*(const GAS v4u*)(OB + (size_t)row * 1024 + c0 + 8 * hh), f2);
#pragma unroll
                for (int i = 0; i < 8; ++i) { f[8 * hh + i] = f1[i] + f2[i]; ss += f[8 * hh + i] * f[8 * hh + i]; } }
            ss += __shfl_xor(ss, 1); ss += __shfl_xor(ss, 2); ss += __shfl_xor(ss, 4);
            const float rstd = rsqrtf(ss * (1.f / 128.f) + EPS_N);
#pragma unroll
            for (int hh = 0; hh < 2; ++hh) { float gg[8]; unpack8(*(const GAS v4u*)(Z + (size_t)row * NO_IN + 4096 + c0 + 8 * hh), gg); float o8[8];
#pragma unroll
                for (int i = 0; i < 8; ++i) o8[i] = f[8 * hh + i] * rstd * gn[8 * hh + i] * (gg[i] * sigmoid_f(gg[i]));
                v4u w; w.x = pk2(o8[0], o8[1]); w.y = pk2(o8[2], o8[3]); w.z = pk2(o8[4], o8[5]); w.w = pk2(o8[6], o8[7]);
                *(GAS v4u*)(O + (size_t)row * 1024 + c0 + 8 * hh) = w; } }
    }
}

constexpr int NPHASES = 34;
__global__ void __launch_bounds__(NTHREADS, 2) mk_fwd(Args args) {
    extern __shared__ __attribute__((aligned(16))) unsigned char lds_raw[];
    LAS unsigned char* lds = (LAS unsigned char*)lds_raw;
    const int tid = threadIdx.x;
    volatile LAS unsigned* MISC = (volatile LAS unsigned*)(lds + MISC_OFF);
    for (int u = tid; u < (LDS_BYTES - LDSCTL_OFF) / 4; u += NTHREADS) ((LAS unsigned*)(lds + LDSCTL_OFF))[u] = 0u;
    __syncthreads();
    if (tid == 0) { LAS unsigned long long* t = (LAS unsigned long long*)(lds + LDSCTL_OFF);
#pragma unroll
        for (int i = 0; i < 20; ++i) t[i] = (unsigned long long)args.in[i];
        t[20] = (unsigned long long)args.out; t[21] = (unsigned long long)args.ws; t[22] = (unsigned long long)(unsigned)args.ph_hi; }
    __syncthreads();
    const Ctx ctx{lds};
    const int ph_lo = args.ph_lo;
    (void)xcd_barrier_post((unsigned*)((gu32*)(ctx.ws() + WS_CTL) + CW_BAR), MISC + 8);
    for (int ph = ph_lo, prep = 0; ph < (int)ctx.rd(22); ++ph) {
        const Ctx& args = ctx;
        int tid = threadIdx.x, bid = blockIdx.x, G = gridDim.x; asm volatile("" : "+v"(tid)); asm volatile("" : "+s"(bid)); asm volatile("" : "+s"(G));
        const int ph_hi = (int)ctx.rd(22), NGW = G * NWAVES;
        const int lane = tid & 63, wave = __builtin_amdgcn_readfirstlane(tid >> 6), gw = bid * NWAVES + wave;
        if (ph == 0) phase_p0(args, lds, tid, lane, wave, bid, G);
        else if (ph == 1) phase_rowpass(args, 0, 0, lane, gw, NGW);
        else {
            const int l = (ph - 2) >> 3, sub = (ph - 2) & 7, e = l >> 1;
            const GAS bf16* Hb = (const GAS bf16*)(args.ws() + WS_H); GAS bf16* Zb = (GAS bf16*)(args.ws() + WS_Z); GAS float* Mb = (GAS float*)(args.ws() + WS_M);
            if (sub == 0) {
                if ((l & 1) == 0) { pg8::Gemm g{Hb, (const GAS bf16*)(args.ws() + WS_WTE_IN) + (size_t)e * NE_IN * 1024, MROWS, NE_IN, 1024}; pg8::StaticOrder S; S.init(MROWS, NE_IN, G, bid);
                    pg8::EpiZ E{Zb, NE_IN, args.out() + OUT_KV, e}; pg8::gemm_phase<pg8::EpiZ, pg8::StaticOrder, true, true>(lds, g, S, E); }
                else { pg8::Gemm g{Hb, (const GAS bf16*)(args.ws() + WS_WTO_IN) + (size_t)e * NO_IN * 1024, MROWS, NO_IN, 1024}; pg8::StaticOrder S; S.init(MROWS, NO_IN, G, bid);
                    pg8::EpiZ E{Zb, NO_IN, nullptr, 0}; pg8::gemm_phase<pg8::EpiZ, pg8::StaticOrder, true, true>(lds, g, S, E); }
            } else if (sub == 1) {
                if ((l & 1) == 0) phase_mix_even(args, lds, tid, bid, G, e); else phase_mix_odd(args, lds, tid, bid, G, e);
            } else if (sub == 2) { if (l & 1) phase_fin(args, l, lane, gw, NGW); }
            else if (sub == 3) {
                const GAS bf16* Wt = ((l & 1) == 0) ? (const GAS bf16*)(args.ws() + WS_WTE_OUT) + (size_t)e * 1048576 : (const GAS bf16*)(args.ws() + WS_WTO_OUT) + (size_t)e * 1048576;
                pg8::Gemm g{Hb, Wt, MROWS, 1024, 1024}; pg8::StaticOrder S; S.init(MROWS, 1024, G, bid);
                pg8::EpiF32 E{Mb, 1024}; pg8::gemm_phase<pg8::EpiF32, pg8::StaticOrder, true, true>(lds, g, S, E);
            } else if (sub == 4) phase_rowpass(args, l, 1, lane, gw, NGW);
            else if (sub == 5) {
                pg8::Gemm g{Hb, (const GAS bf16*)(args.ws() + WS_WTF_IN) + (size_t)l * NFF_IN * 1024, MROWS, NFF_IN, 1024}; pg8::StaticOrder S; S.init(MROWS, NFF_IN, G, bid);
                pg8::EpiSwiglu E{Zb, DFF}; pg8::gemm_phase<pg8::EpiSwiglu, pg8::StaticOrder, true, true>(lds, g, S, E);
            } else if (sub == 6) {
                pg8::Gemm g{Zb, (const GAS bf16*)(args.ws() + WS_WTF_OUT) + (size_t)l * 1024 * DFF, MROWS, 1024, DFF}; pg8::StaticOrder S; S.init(MROWS, 1024, G, bid);
                pg8::EpiF32 E{Mb, 1024}; pg8::gemm_phase<pg8::EpiF32, pg8::StaticOrder, true, true>(lds, g, S, E);
            } else phase_rowpass(args, l, 2, lane, gw, NGW);
        }
        if (ph + 1 < ph_hi) { XcdBarrier bar; bar.bar = (unsigned*)((gu32*)(ctx.ws() + WS_CTL) + CW_BAR); bar.x = xb_xcc_id(); bar.st = MISC + 8; xcd_barrier(bar); }
#ifdef PROBE_MASK
        { const int sub_ = (ph - 2) & 7, l_ = (ph - 2) >> 3; int cat = -1;
          if (ph == 0) cat = 4; else if (ph >= 2) { if (sub_ == 0 || sub_ == 3 || sub_ == 5 || sub_ == 6) cat = 0; else if (sub_ == 1) cat = (l_ & 1) ? 2 : 1; else if (sub_ == 2) cat = 3; }
          if (cat >= 0 && ((PROBE_MASK >> cat) & 1) && prep == 0) { prep = 1; --ph; } else prep = 0; }
#endif
    }
}

extern "C" void kernel_launch(void* const* d_in, const int* in_sizes, int n_in, void* d_out, int out_size, void* d_ws, size_t ws_size, hipStream_t stream) {
    static int grid = 0;
    if (grid == 0) {
        if (n_in != 20 || ws_size < WS_END) { fprintf(stderr, "kernel_launch: need 20 inputs and >= %zu bytes of workspace; got n_in %d, ws %zu\n", (size_t)WS_END, n_in, ws_size); grid = -1; return; }
        int dev = 0, cus = 0, per_cu = 0;
        if (hipGetDevice(&dev) != hipSuccess || hipDeviceGetAttribute(&cus, hipDeviceAttributeMultiprocessorCount, dev) != hipSuccess) { fprintf(stderr, "kernel_launch: device query failed\n"); grid = -1; return; }
        if (hipFuncSetAttribute((const void*)mk_fwd, hipFuncAttributeMaxDynamicSharedMemorySize, LDS_BYTES) != hipSuccess) { fprintf(stderr, "kernel_launch: hipFuncSetAttribute failed\n"); grid = -1; return; }
        if (hipOccupancyMaxActiveBlocksPerMultiprocessor(&per_cu, (const void*)mk_fwd, NTHREADS, LDS_BYTES) != hipSuccess || per_cu < 1) { fprintf(stderr, "kernel_launch: occupancy query reports %d blocks per CU\n", per_cu); per_cu = 1; }
        (void)hipGetLastError();
        grid = cus;
    }
    if (grid < 0) return;
    (void)hipMemsetAsync((char*)d_ws + WS_CTL, 0, CTL_ZERO_BYTES, stream);
    Args a{};
    for (int i = 0; i < 20; ++i) a.in[i] = (const float*)d_in[i];
    a.out = (float*)d_out; a.ws = (unsigned char*)d_ws;
#if MK_PER_PHASE
    for (int ph = 0; ph < NPHASES; ++ph) { a.ph_lo = ph; a.ph_hi = ph + 1; hipLaunchKernelGGL(mk_fwd, dim3(grid), dim3(NTHREADS), LDS_BYTES, stream, a); }
#else
    a.ph_lo = 0; a.ph_hi = NPHASES;
    void* params[] = {&a};
    hipError_t e = hipLaunchCooperativeKernel((const void*)mk_fwd, dim3(grid), dim3(NTHREADS), params, LDS_BYTES, stream);
    if (e != hipSuccess) fprintf(stderr, "kernel_launch: cooperative launch failed: %s (grid %d)\n", hipGetErrorString(e), grid);
#endif
}
```
